# Optimizing an MI355X kernel written in HIP

```python
import jax, jax.numpy as jnp
from jax import lax
import numpy as np

D_MODEL = 1024
BATCH = 4
SEQ = 8192
DEPTH = 2

GRID_W = 64
CTX_LEN = 256
HEAD_DIM = 64
D_A = D_MODEL // 2
D_B = D_MODEL // 4
D_C = D_MODEL // 4
D_MIX = D_A + D_B + D_C
H_A = D_A // HEAD_DIM
H_B = D_B // HEAD_DIM
H_C = D_C // HEAD_DIM
D_IN = 2 * D_A + 2 * D_B + D_C
CHUNK = 128
CONV_W = 4
CONV_LEFT = 2
RG_C = 8.0
D_FF = -(-(8 * D_MODEL) // (3 * 256)) * 256
N_MOD = 6
DEEPNORM_ALPHA = (2 * DEPTH) ** 0.25
DEEPNORM_BETA = (8 * DEPTH) ** -0.25
LN_EPS = 1e-6
POS_BASE = 10000.0

kernel_name = "hybrid_rglru_chunkmlp_fourier_dit"


def layer_norm(x, g=None, b=None):
    xf = x.astype(jnp.float32)
    mu = jnp.mean(xf, -1, keepdims=True)
    var = jnp.mean(jnp.square(xf - mu), -1, keepdims=True)
    y = (xf - mu) * lax.rsqrt(var + LN_EPS)
    if g is not None:
        y = y * g.astype(jnp.float32) + b.astype(jnp.float32)
    return y.astype(x.dtype)


def rms_norm(x, g):
    xf = x.astype(jnp.float32)
    y = xf * lax.rsqrt(jnp.mean(jnp.square(xf), -1, keepdims=True) + LN_EPS)
    return (y * g.astype(jnp.float32)).astype(x.dtype)


def pos_embed_2d(rows, dim):
    quarter = dim // 4
    freqs = POS_BASE ** (-jnp.arange(quarter, dtype=jnp.float32) / quarter)
    r = jnp.repeat(jnp.arange(rows, dtype=jnp.float32), GRID_W)
    col = jnp.tile(jnp.arange(GRID_W, dtype=jnp.float32), rows)

    def enc(p):
        ang = p[:, None] * freqs[None, :]
        return jnp.concatenate([jnp.sin(ang), jnp.cos(ang)], -1)

    return jnp.concatenate([enc(r), enc(col)], -1)


def dwconv_centred(x, w, b):
    L = x.shape[1]
    xp = jnp.pad(x, ((0, 0), (CONV_LEFT, CONV_W - 1 - CONV_LEFT), (0, 0)))
    y = b
    for k in range(CONV_W):
        y = y + w[k] * xp[:, k:k + L]
    return y


def _combine(left, right):
    a_l, b_l = left
    a_r, b_r = right
    return a_l * a_r, a_r * b_l + b_r


def linear_scan(a, b, reverse):
    return lax.associative_scan(_combine, (a, b), reverse=reverse, axis=1)


def rglru_bidir(xa, conv_w, conv_b, wa, ba, wx, bx, lam, h0=None):
    Bsz, L, _ = xa.shape
    xc = dwconv_centred(xa, conv_w, conv_b).astype(jnp.float32)
    xh = xc.reshape(Bsz, L, H_A, HEAD_DIM)
    r = jax.nn.sigmoid(jnp.einsum("blhc,dhce->dblhe", xh, wa.astype(jnp.float32)).reshape(2, Bsz, L, D_A)
                       + ba.astype(jnp.float32)[:, None, None])
    i = jax.nn.sigmoid(jnp.einsum("blhc,dhce->dblhe", xh, wx.astype(jnp.float32)).reshape(2, Bsz, L, D_A)
                       + bx.astype(jnp.float32)[:, None, None])
    log_a = -RG_C * r * jax.nn.softplus(-lam.astype(jnp.float32))[:, None, None]
    a = jnp.exp(log_a)
    u = jnp.sqrt(-jnp.expm1(2.0 * log_a)) * (i * xc[None])
    acum_f, h_f = linear_scan(a[0], u[0], False)
    acum_b, h_b = linear_scan(a[1], u[1], True)
    if h0 is not None:
        h_f = h_f + acum_f * h0[0][:, None]
        h_b = h_b + acum_b * h0[1][:, None]
    return h_f, h_b


def spatial_gating(uv, ws, bs):
    Bsz, L, _ = uv.shape
    z = jax.nn.gelu(uv, approximate=False)
    u, v = z[..., :D_B], z[..., D_B:]
    v = layer_norm(v.reshape(Bsz, L // CHUNK, CHUNK, H_B, HEAD_DIM))
    s = jnp.einsum("hpq,bnqhc->bnphc", ws, v) + jnp.transpose(bs)[:, :, None]
    return u * s.reshape(Bsz, L, D_B)


def fourier_mix(xf, wf):
    Bsz, L, _ = xf.shape
    z = xf.reshape(Bsz, L, H_C, HEAD_DIM).astype(jnp.float32)
    f = jnp.fft.fft2(z, axes=(1, 3), norm="ortho").real
    return jnp.einsum("blhc,hce->blhe", f, wf.astype(jnp.float32)).reshape(Bsz, L, D_C).astype(xf.dtype)


def mix_outputs(p, h_lru, sg_ws, sg_b, fourier_w, g_mix, w_out):
    y_a = jax.nn.gelu(p[..., D_A:2 * D_A], approximate=False) * h_lru.astype(p.dtype)
    y_b = spatial_gating(p[..., 2 * D_A:2 * D_A + 2 * D_B], sg_ws, sg_b)
    y_c = fourier_mix(p[..., 2 * D_A + 2 * D_B:], fourier_w)
    y = jnp.concatenate([rms_norm(y_a, g_mix[:D_A]),
                         rms_norm(y_b, g_mix[D_A:D_A + D_B]),
                         rms_norm(y_c, g_mix[D_A + D_B:])], -1)
    return y @ w_out


def swiglu(h, w_up, w_down):
    gu = h @ w_up
    return (jax.nn.silu(gu[..., :D_FF]) * gu[..., D_FF:]) @ w_down


def setup_inputs(seed: int = 0) -> dict:
    key = jax.random.key(seed)
    ks = jax.random.split(key, 26)
    f32 = jnp.float32

    def nrm(k, shape, s):
        return jax.random.normal(k, shape, f32) * s

    a0 = jax.random.uniform(ks[13], (DEPTH, 2, D_A), f32, 0.9, 0.999)
    return {
        "x": nrm(ks[0], (BATCH, SEQ, D_MODEL), 1.0),
        "c": nrm(ks[1], (BATCH, D_MODEL), 1.0),
        "ctx": nrm(ks[2], (BATCH, CTX_LEN, D_MODEL), 1.0),
        "c_ctx": nrm(ks[3], (D_MODEL,), 1.0),
        "w_mod": nrm(ks[4], (DEPTH, D_MODEL, N_MOD * D_MODEL), 0.5 * D_MODEL ** -0.5),
        "b_mod": nrm(ks[5], (DEPTH, N_MOD * D_MODEL), 0.02),
        "w_in": nrm(ks[6], (DEPTH, D_MODEL, D_IN), D_MODEL ** -0.5),
        "conv_w": nrm(ks[7], (DEPTH, CONV_W, D_A), CONV_W ** -0.5),
        "conv_b": nrm(ks[8], (DEPTH, D_A), 0.02),
        "lru_wa": nrm(ks[9], (DEPTH, 2, H_A, HEAD_DIM, HEAD_DIM), HEAD_DIM ** -0.5),
        "lru_ba": nrm(ks[10], (DEPTH, 2, D_A), 0.02),
        "lru_wx": nrm(ks[11], (DEPTH, 2, H_A, HEAD_DIM, HEAD_DIM), HEAD_DIM ** -0.5),
        "lru_bx": nrm(ks[12], (DEPTH, 2, D_A), 0.02),
        "lru_lam": jnp.log(a0) - jnp.log1p(-a0),
        "sg_ws": nrm(ks[14], (DEPTH, H_B, CHUNK, CHUNK), CHUNK ** -0.5),
        "sg_b": 1.0 + nrm(ks[15], (DEPTH, H_B, CHUNK), 0.02),
        "fourier_w": nrm(ks[16], (DEPTH, H_C, HEAD_DIM, HEAD_DIM), HEAD_DIM ** -0.5),
        "g_mix": 1.0 + nrm(ks[17], (DEPTH, D_MIX), 0.02),
        "w_out": nrm(ks[18], (DEPTH, D_MIX, D_MODEL), DEEPNORM_BETA * D_MIX ** -0.5),
        "ln1_g": 1.0 + nrm(ks[19], (DEPTH, D_MODEL), 0.02),
        "ln1_b": nrm(ks[20], (DEPTH, D_MODEL), 0.02),
        "w_up": nrm(ks[21], (DEPTH, D_MODEL, 2 * D_FF), D_MODEL ** -0.5),
        "w_down": nrm(ks[22], (DEPTH, D_FF, D_MODEL), DEEPNORM_BETA * D_FF ** -0.5),
        "ln2_g": 1.0 + nrm(ks[23], (DEPTH, D_MODEL), 0.02),
        "ln2_b": nrm(ks[24], (DEPTH, D_MODEL), 0.02),
    }


def reference(x, c, ctx, c_ctx, w_mod, b_mod, w_in, conv_w, conv_b, lru_wa, lru_ba, lru_wx, lru_bx,
              lru_lam, sg_ws, sg_b, fourier_w, g_mix, w_out, ln1_g, ln1_b, w_up, w_down, ln2_g, ln2_b):
    Bsz, L, D = x.shape
    rows = L // GRID_W
    xl = x + pos_embed_2d(rows, D).astype(x.dtype)[None]
    xc = ctx
    sc = jax.nn.silu(c)
    sc_ctx = jax.nn.silu(c_ctx)
    for l in range(DEPTH):
        last = l == DEPTH - 1
        mod_l = (sc @ w_mod[l] + b_mod[l]).reshape(Bsz, N_MOD, 1, D)
        mod_c = (sc_ctx @ w_mod[l] + b_mod[l]).reshape(N_MOD, 1, 1, D)
        lru = (conv_w[l], conv_b[l], lru_wa[l], lru_ba[l], lru_wx[l], lru_bx[l], lru_lam[l])
        mix = (sg_ws[l], sg_b[l], fourier_w[l], g_mix[l], w_out[l])

        hc = layer_norm(xc) * (1.0 + mod_c[1]) + mod_c[0]
        hl = layer_norm(xl) * (1.0 + mod_l[:, 1]) + mod_l[:, 0]
        if last:
            hf_c, hb_c = rglru_bidir(hc @ w_in[l][:, :D_A], *lru)
        else:
            pc = hc @ w_in[l]
            hf_c, hb_c = rglru_bidir(pc[..., :D_A], *lru)
            yc = mix_outputs(pc, hf_c + hb_c, *mix)
        pl = hl @ w_in[l]
        hf_l, hb_l = rglru_bidir(pl[..., :D_A], *lru, h0=(hf_c[:, -1], hb_c[:, 0]))
        yl = mix_outputs(pl, hf_l + hb_l, *mix)
        xl = layer_norm(DEEPNORM_ALPHA * xl + mod_l[:, 2] * yl, ln1_g[l], ln1_b[l])

        hl = layer_norm(xl) * (1.0 + mod_l[:, 4]) + mod_l[:, 3]
        xl = layer_norm(DEEPNORM_ALPHA * xl + mod_l[:, 5] * swiglu(hl, w_up[l], w_down[l]), ln2_g[l], ln2_b[l])

        if not last:
            xc = layer_norm(DEEPNORM_ALPHA * xc + mod_c[2] * yc, ln1_g[l], ln1_b[l])
            hc = layer_norm(xc) * (1.0 + mod_c[4]) + mod_c[3]
            xc = layer_norm(DEEPNORM_ALPHA * xc + mod_c[5] * swiglu(hc, w_up[l], w_down[l]), ln2_g[l], ln2_b[l])
    return xl
```

```cpp
#include <hip/hip_runtime.h>
#include <hip/hip_cooperative_groups.h>
#ifndef MIX3_REP_MODE
#define MIX3_REP_MODE 15
#endif
#ifndef MIX1_REP_MODE
#define MIX1_REP_MODE 3
#endif
#include <cstdint>
#include <cstdio>
#include <cmath>

namespace cg = cooperative_groups;
namespace pg8 {
#define PG8_LAS __attribute__((address_space(3)))
typedef unsigned short bf16_t;
typedef short bf16x8 __attribute__((ext_vector_type(8)));
typedef float f32x4 __attribute__((ext_vector_type(4)));
typedef unsigned u32x4 __attribute__((ext_vector_type(4)));
constexpr int BM = 256, BK = 64, HALF = 128, HTB = HALF * BK * 2  , STAGE_BYTES = 8 * HTB, NXCD = 8, WGM = 8;

__host__ __device__ __forceinline__ int lds_byte(int r, int c) { const int st = (r >> 4) * 2 + (c >> 5), rr = r & 15, cc = c & 31, ob = rr * 64 + cc * 2; return st * 1024 + (ob ^ (((ob >> 9) & 1) << 5)); }
__host__ __device__ __forceinline__ void stage_rc(int b, int& R, int& C) { const int st = b / 1024, sb = b % 1024, swz = sb ^ (((sb >> 9) & 1) << 5); R = (st >> 1) * 16 + swz / 64; C = (st & 1) * 32 + (swz % 64) / 2; }
__host__ __device__ __forceinline__ int perm32(int rho) { const int n = rho >> 4, i = rho & 15; return 8 * (i >> 2) + 4 * n + (i & 3); }

struct Unit { int pm, pn; };
struct Gemm { const bf16_t* A; const bf16_t* Bt; int M, N, K, pad; };

struct StaticOrder {
    int nM, nN, nwg, G, c;
    __host__ __device__ void init(int M, int N, int G_, int c_) { nM = M / BM; nN = N / BM; nwg = nM * nN; G = G_; c = c_; }
    __host__ __device__ bool next(int i, Unit& u) const {
        const long L = (long)i * G + c; if (L >= nwg) return false;
        int wgid = (int)L; { const int q = nwg / NXCD, r = nwg % NXCD, xcd = wgid % NXCD, off = wgid / NXCD; wgid = (xcd < r ? xcd * (q + 1) : r * (q + 1) + (xcd - r) * q) + off; }
        const int nig = WGM * nN, gid = wgid / nig, fm = gid * WGM, gsz = (nM - fm) < WGM ? (nM - fm) : WGM;
        u.pm = fm + ((wgid % nig) % gsz); u.pn = (wgid % nig) / gsz; return true;
    }
    __device__ __forceinline__ void a_ready(const Unit&) const {}
    __device__ __forceinline__ void done(const Unit&) const {}
};

__device__ __forceinline__ unsigned cvt_pk_bf16(float lo, float hi) { unsigned r; asm volatile("v_cvt_pk_bf16_f32 %0, %1, %2" : "=v"(r) : "v"(lo), "v"(hi)); return r; }
typedef float f32x2 __attribute__((ext_vector_type(2)));
__device__ __forceinline__ f32x2 gelu_pk(f32x2 v) {
    const f32x2 av = __builtin_elementwise_abs(v), d = av * 0.2316418882f + 1.0f;
    f32x2 t; t.x = __builtin_amdgcn_rcpf(d.x); t.y = __builtin_amdgcn_rcpf(d.y);
    f32x2 q = t * 0.5307027145f + (-0.7265760135f); q = q * t + 0.7107068705f; q = q * t + (-0.142248368f); q = q * t + 0.127414796f; q = q * t;
    const f32x2 s = (v * v) * (-0.72134752044f);
    f32x2 e; e.x = __builtin_amdgcn_exp2f(s.x); e.y = __builtin_amdgcn_exp2f(s.y);
    const f32x2 m = v * (q * e), r = v - m;
    f32x2 o; o.x = v.x < 0.f ? m.x : r.x; o.y = v.y < 0.f ? m.y : r.y; return o;
}

template <int ACT  > struct EpiBf16 {
    static constexpr bool PERM = true, AFTER_DRAIN = false; static_assert(ACT == 0 || ACT == 1, "EpiBf16: ACT is 0 (none) or 1 (gelu_pk)");
    bf16_t* O; int ldc; const float* bias; int split_cols; size_t split_stride; float scale0;
    __device__ __forceinline__ void operator()(const f32x4 (&acc)[2][2][4][2], const Unit& u, int wr, int wc, int fr, int fq) const {
        const int row0 = u.pm * BM + wr * 64 + fr; int colt = u.pn * BM; bf16_t* base = O;
        float sc = 1.f; if (split_cols) { const int t = colt / split_cols; base += (size_t)t * split_stride; colt -= t * split_cols; if (t == 0) sc = scale0; }
        const int col0 = colt + wc * 32 + 8 * fq, bcol0 = u.pn * BM + wc * 32 + 8 * fq;
        f32x4 bv[2][2];
#pragma unroll
        for (int bj = 0; bj < 2; ++bj)
#pragma unroll
            for (int n = 0; n < 2; ++n) bv[bj][n] = bias ? *(const f32x4*)(bias + bcol0 + bj * HALF + 4 * n) : (f32x4){0.f, 0.f, 0.f, 0.f};
#pragma unroll
        for (int ai = 0; ai < 2; ++ai)
#pragma unroll
            for (int m = 0; m < 4; ++m) { bf16_t* rowp = base + (size_t)(row0 + ai * HALF + m * 16) * ldc + col0;
#pragma unroll
                for (int bj = 0; bj < 2; ++bj) { f32x4 v0 = acc[ai][bj][m][0] + bv[bj][0], v1 = acc[ai][bj][m][1] + bv[bj][1];
                    if (ACT == 1) { f32x2 a = gelu_pk((f32x2){v0[0], v0[1]}), b = gelu_pk((f32x2){v0[2], v0[3]}), c = gelu_pk((f32x2){v1[0], v1[1]}), d = gelu_pk((f32x2){v1[2], v1[3]});
                        v0 = (f32x4){a.x, a.y, b.x, b.y}; v1 = (f32x4){c.x, c.y, d.x, d.y}; }
                    v0 = v0 * sc; v1 = v1 * sc; u32x4 w; w.x = cvt_pk_bf16(v0[0], v0[1]); w.y = cvt_pk_bf16(v0[2], v0[3]); w.z = cvt_pk_bf16(v1[0], v1[1]); w.w = cvt_pk_bf16(v1[2], v1[3]);
                    *(u32x4*)(rowp + bj * HALF) = w; } }
    }
};

struct EpiF32 {
    static constexpr bool PERM = false, AFTER_DRAIN = false;
    float* C; const float* bias; int ldc, pad;
    __device__ __forceinline__ void operator()(const f32x4 (&acc)[2][2][4][2], const Unit& u, int wr, int wc, int fr, int fq) const {
        const int row0 = u.pm * BM + wr * 64 + fr, col0 = u.pn * BM + wc * 32 + 4 * fq;
        f32x4 bv[2][2];
#pragma unroll
        for (int bj = 0; bj < 2; ++bj)
#pragma unroll
            for (int n = 0; n < 2; ++n) bv[bj][n] = bias ? *(const f32x4*)(bias + col0 + bj * HALF + n * 16) : (f32x4){0.f, 0.f, 0.f, 0.f};
#pragma unroll
        for (int ai = 0; ai < 2; ++ai)
#pragma unroll
            for (int m = 0; m < 4; ++m) { float* rowp = C + (size_t)(row0 + ai * HALF + m * 16) * ldc + col0;
#pragma unroll
                for (int bj = 0; bj < 2; ++bj)
#pragma unroll
                    for (int n = 0; n < 2; ++n) *(f32x4*)(rowp + bj * HALF + n * 16) = acc[ai][bj][m][n] + bv[bj][n]; }
    }
};

template <class Epi, class Sched, bool ALIGN_EPI = false, bool SP2 = false>
__device__ __forceinline__ void gemm_phase(PG8_LAS unsigned char* lds, const Gemm g, const Sched& S, const Epi& E, int wv_) {
    int ln_; asm volatile("v_mbcnt_lo_u32_b32 %0, -1, 0\n\tv_mbcnt_hi_u32_b32 %0, -1, %0" : "=v"(ln_)); const int tid_ = (wv_ << 6) | ln_;
    const int tid = tid_, wid = __builtin_amdgcn_readfirstlane(tid >> 6), lane = tid & 63, wr = wid >> 2, wc = wid & 3, fr = lane & 15, fq = lane >> 4;
    const int K = g.K, nt = K / BK;
    unsigned voffA[2], voffB[2];
#pragma unroll
    for (int i = 0; i < 2; ++i) { int R, C; stage_rc(tid * 16 + i * 8192, R, C); const int Rb = Epi::PERM ? ((R & ~31) + perm32(R & 31)) : R;
        voffA[i] = (unsigned)(R * K + C) * 2u; voffB[i] = (unsigned)(Rb * K + C) * 2u; }
    const size_t kstep = (size_t)(BK * 2);
    const size_t hstep = (size_t)HALF * K * 2;
    const size_t tstep = 2 * hstep;
    const unsigned ldsw = (unsigned)wid * 1024u;
    const int aoff = lds_byte(wr * 64 + fr, fq * 8), boff = lds_byte(wc * 32 + fr, fq * 8);
#define PG8_SA(b, h) (((b) * 2 + (h)) * HTB)
#define PG8_SB(b, h) ((4 + (b) * 2 + (h)) * HTB)
#define PG8_STAGE(bufoff, gbase, voff) do { _Pragma("unroll") for (int _i = 0; _i < 2; ++_i) \
        __builtin_amdgcn_global_load_lds((const unsigned*)((const char*)(gbase) + (voff)[_i]), (PG8_LAS unsigned*)(lds + (bufoff) + ldsw + _i * 8192), 16, 0, 0); } while (0)
#define PG8_LDA(dst, b, h) do { _Pragma("unroll") for (int m = 0; m < 4; ++m) _Pragma("unroll") for (int k = 0; k < 2; ++k) dst[m][k] = *(const PG8_LAS bf16x8*)(lds + PG8_SA(b, h) + aoff + m * 2048 + k * 1024); } while (0)
#define PG8_LDB(dst, b, h) do { _Pragma("unroll") for (int n = 0; n < 2; ++n) _Pragma("unroll") for (int k = 0; k < 2; ++k) dst[n][k] = *(const PG8_LAS bf16x8*)(lds + PG8_SB(b, h) + boff + n * 2048 + k * 1024); } while (0)
#define PG8_MMA(ai, bj, At, Bt) do { __builtin_amdgcn_s_setprio(1); _Pragma("unroll") for (int m = 0; m < 4; ++m) _Pragma("unroll") for (int n = 0; n < 2; ++n) _Pragma("unroll") for (int k = 0; k < 2; ++k) \
        acc[ai][bj][m][n] = __builtin_amdgcn_mfma_f32_16x16x32_bf16(Bt[n][k], At[m][k], acc[ai][bj][m][n], 0, 0, 0); __builtin_amdgcn_s_setprio(0); } while (0)
#define PG8_WAIT_V(n) asm volatile("s_waitcnt vmcnt(" #n ")" ::: "memory")
#define PG8_WAIT_L(n) asm volatile("s_waitcnt lgkmcnt(" #n ")" ::: "memory")
#define PG8_BAR __builtin_amdgcn_s_barrier()
#define PG8_SCHED __builtin_amdgcn_sched_barrier(0)
    Unit cur, nxt; int ui = 0;
    if (!S.next(0, cur)) return;
    f32x4 acc[2][2][4][2];
#pragma unroll
    for (int a = 0; a < 2; ++a)
#pragma unroll
        for (int b = 0; b < 2; ++b)
#pragma unroll
            for (int m = 0; m < 4; ++m)
#pragma unroll
                for (int n = 0; n < 2; ++n) acc[a][b][m][n] = (f32x4){0.f, 0.f, 0.f, 0.f};
    bf16x8 At[4][2], B0[2][2], B1[2][2];
    const char* cA = (const char*)g.A + (size_t)cur.pm * tstep; const char* cB = (const char*)g.Bt + (size_t)cur.pn * tstep;
    S.a_ready(cur);
    if constexpr (SP2) {
        PG8_STAGE(PG8_SB(0, 0), cB, voffB); PG8_STAGE(PG8_SB(0, 1), cB + hstep, voffB); PG8_STAGE(PG8_SA(0, 0), cA, voffA); PG8_STAGE(PG8_SA(0, 1), cA + hstep, voffA);
        if (wr == 1) PG8_BAR;
        PG8_WAIT_V(2); PG8_BAR;
        PG8_STAGE(PG8_SB(1, 0), cB + kstep, voffB); PG8_STAGE(PG8_SA(1, 0), cA + kstep, voffA); PG8_STAGE(PG8_SB(1, 1), cB + hstep + kstep, voffB);
        PG8_WAIT_V(6); PG8_BAR;
    } else {
        PG8_STAGE(PG8_SB(0, 0), cB, voffB); PG8_STAGE(PG8_SA(0, 0), cA, voffA); PG8_STAGE(PG8_SB(0, 1), cB + hstep, voffB); PG8_STAGE(PG8_SA(0, 1), cA + hstep, voffA);
        if (wr == 1) PG8_BAR;
        PG8_WAIT_V(4); PG8_BAR;
        PG8_STAGE(PG8_SB(1, 0), cB + kstep, voffB); PG8_STAGE(PG8_SA(1, 0), cA + kstep, voffA); PG8_STAGE(PG8_SB(1, 1), cB + hstep + kstep, voffB);
        PG8_WAIT_V(6); PG8_BAR;
    }
    for (;;) {
        const bool has_next = S.next(ui + 1, nxt);
        const char* nA = has_next ? (const char*)g.A + (size_t)nxt.pm * tstep : cA; const char* nB = has_next ? (const char*)g.Bt + (size_t)nxt.pn * tstep : cB;
        for (int t = 0; t < nt; t += 2) {
            const bool last = (t == nt - 2);
            const char* a1 = cA + (size_t)(t + 1) * kstep;
            const char* a2 = last ? nA : cA + (size_t)(t + 2) * kstep; const char* b2 = last ? nB : cB + (size_t)(t + 2) * kstep;
            const char* a3 = a2 + kstep; const char* b3 = b2 + kstep;
            if (last && has_next) S.a_ready(nxt);
            if constexpr (SP2) {
            PG8_LDB(B0, 0, 0); PG8_LDB(B1, 0, 1); PG8_SCHED; PG8_LDA(At, 0, 0); PG8_STAGE(PG8_SA(1, 1), a1 + hstep, voffA);
            PG8_WAIT_V(8); PG8_WAIT_L(0); PG8_BAR; PG8_MMA(0, 0, At, B0); PG8_MMA(0, 1, At, B1); PG8_BAR; PG8_SCHED;
            PG8_LDA(At, 0, 1); PG8_STAGE(PG8_SB(0, 0), b2, voffB); PG8_STAGE(PG8_SB(0, 1), b2 + hstep, voffB); PG8_STAGE(PG8_SA(0, 0), a2, voffA);
            PG8_WAIT_V(8); PG8_WAIT_L(0); PG8_BAR; PG8_MMA(1, 0, At, B0); PG8_MMA(1, 1, At, B1); PG8_BAR; PG8_SCHED;
            PG8_LDB(B0, 1, 0); PG8_LDB(B1, 1, 1); PG8_SCHED; PG8_LDA(At, 1, 0); PG8_STAGE(PG8_SA(0, 1), a2 + hstep, voffA);
            PG8_WAIT_V(8); PG8_WAIT_L(0); PG8_BAR; PG8_MMA(0, 0, At, B0); PG8_MMA(0, 1, At, B1); PG8_BAR; PG8_SCHED;
            PG8_LDA(At, 1, 1); PG8_STAGE(PG8_SB(1, 0), b3, voffB); PG8_STAGE(PG8_SB(1, 1), b3 + hstep, voffB); PG8_STAGE(PG8_SA(1, 0), a3, voffA);
            PG8_WAIT_V(8); PG8_WAIT_L(0); PG8_BAR; PG8_MMA(1, 0, At, B0); PG8_MMA(1, 1, At, B1); PG8_BAR; PG8_SCHED;
            } else {
            PG8_LDB(B0, 0, 0); PG8_SCHED; PG8_LDA(At, 0, 0); PG8_STAGE(PG8_SA(1, 1), a1 + hstep, voffA);
            PG8_WAIT_L(8); PG8_BAR; PG8_WAIT_L(0); PG8_MMA(0, 0, At, B0); PG8_BAR; PG8_SCHED;
            PG8_LDB(B1, 0, 1); PG8_STAGE(PG8_SB(0, 0), b2, voffB);
            PG8_BAR; PG8_WAIT_L(0); PG8_MMA(0, 1, At, B1); PG8_BAR;
            PG8_LDA(At, 0, 1); PG8_STAGE(PG8_SA(0, 0), a2, voffA);
            PG8_BAR; PG8_WAIT_L(0); PG8_MMA(1, 0, At, B0); PG8_BAR; PG8_SCHED;
            PG8_STAGE(PG8_SB(0, 1), b2 + hstep, voffB);
            PG8_WAIT_V(6); PG8_BAR; PG8_MMA(1, 1, At, B1); PG8_BAR;
            PG8_LDB(B0, 1, 0); PG8_SCHED; PG8_LDA(At, 1, 0); PG8_STAGE(PG8_SA(0, 1), a2 + hstep, voffA);
            PG8_WAIT_L(8); PG8_BAR; PG8_WAIT_L(0); PG8_MMA(0, 0, At, B0); PG8_BAR; PG8_SCHED;
            PG8_LDB(B1, 1, 1); PG8_STAGE(PG8_SB(1, 0), b3, voffB);
            PG8_BAR; PG8_WAIT_L(0); PG8_MMA(0, 1, At, B1); PG8_BAR;
            PG8_LDA(At, 1, 1); PG8_STAGE(PG8_SA(1, 0), a3, voffA);
            PG8_BAR; PG8_WAIT_L(0); PG8_MMA(1, 0, At, B0); PG8_BAR; PG8_SCHED;
            PG8_STAGE(PG8_SB(1, 1), b3 + hstep, voffB);
            PG8_WAIT_V(6); PG8_BAR; PG8_MMA(1, 1, At, B1); PG8_BAR;
            }
        }
        if constexpr (ALIGN_EPI) { if (wr == 0) PG8_BAR; }
        if constexpr (!Epi::AFTER_DRAIN) { E(acc, cur, wr, wc, fr, fq); S.done(cur); }
        if (!has_next) break;
#pragma unroll
        for (int a = 0; a < 2; ++a)
#pragma unroll
            for (int b = 0; b < 2; ++b)
#pragma unroll
                for (int m = 0; m < 4; ++m)
#pragma unroll
                    for (int n = 0; n < 2; ++n) acc[a][b][m][n] = (f32x4){0.f, 0.f, 0.f, 0.f};
        cur = nxt; cA = nA; cB = nB; ++ui;
        if constexpr (ALIGN_EPI) { if (wr == 1) PG8_BAR; }
    }
    PG8_WAIT_V(0);
    if constexpr (!ALIGN_EPI) { if (wr == 0) PG8_BAR; }
    PG8_BAR;
    if constexpr (Epi::AFTER_DRAIN) { E.fused(acc, cur, wr, wc, fr, fq, lds, wid, lane); S.done(cur); }
#undef PG8_SA
#undef PG8_SB
#undef PG8_STAGE
#undef PG8_LDA
#undef PG8_LDB
#undef PG8_MMA
#undef PG8_WAIT_V
#undef PG8_WAIT_L
#undef PG8_BAR
#undef PG8_SCHED
}
}

namespace {
constexpr int D = 1024, NB = 4, SEQ = 8192, CTX = 256, DEPTH = 2;
constexpr int DA = 512, DB = 256, DC = 256, DIN = 1792, HD = 64, CHUNK = 128, DFF = 2816, NMOD = 6;
constexpr int NLAT = NB * SEQ, NCTX = NB * CTX;
constexpr float LN_EPS = 1e-6f;
constexpr float ALPHA = 1.41421356237309515f;
constexpr float PI_F = 3.14159265358979323846f;

typedef unsigned short bf16_t;
__device__ __forceinline__ bf16_t f2bf(float f) { unsigned r; asm("v_cvt_pk_bf16_f32 %0, %1, %1" : "=v"(r) : "v"(f)); return (bf16_t)(r & 0xffffu); }
__device__ __forceinline__ float bf2f(bf16_t h) { return __builtin_bit_cast(float, (unsigned)h << 16); }
__device__ __forceinline__ void st_val(float* p, float v) { *p = v; }
__device__ __forceinline__ void st_val(bf16_t* p, float v) { *p = f2bf(v); }
__device__ __forceinline__ float gelu_f(float v) { return 0.5f * v * (1.0f + erff(v * 0.70710678118654752f)); }
__device__ __forceinline__ float sigmoid_f(float v) { return 1.0f / (1.0f + expf(-v)); }
__device__ __forceinline__ float silu_f(float v) { return v / (1.0f + expf(-v)); }

__device__ __forceinline__ float block_sum256(float v, float* sh) {
#pragma unroll
    for (int o = 32; o > 0; o >>= 1) v += __shfl_xor(v, o);
    __syncthreads();
    if ((threadIdx.x & 63) == 0) sh[threadIdx.x >> 6] = v;
    __syncthreads();
    return (sh[0] + sh[1]) + (sh[2] + sh[3]);
}

constexpr int NTOK = NLAT + NCTX, NCHUNK = NTOK / CHUNK;
constexpr size_t al256(size_t x) { return (x + 255) & ~(size_t)255; }
constexpr size_t WS_MOD = 0;
constexpr size_t WS_TAB = WS_MOD + al256((size_t)DEPTH * 5 * NMOD * D * 4);
constexpr size_t WS_XCTX = WS_TAB + al256((size_t)2 * 8192 * 4);
constexpr size_t WS_HC = WS_XCTX + al256((size_t)NCTX * D * 4);
constexpr size_t WS_AGG = WS_HC + al256((size_t)NB * 2 * DA * 4);
constexpr size_t WS_T = WS_AGG + al256((size_t)NCHUNK * 2 * 2 * DA * 4);
constexpr size_t WS_MM = WS_T + al256((size_t)256 * 256 * 2);
constexpr int SM_CONVW = 0, SM_CONVB = 2048, SM_BA = 2560, SM_BX = 3584, SM_SP8 = 4608, SM_SGB = 5632, SM_GMIX = 6144, SM_LN1G = 7168, SM_LN1B = 8192, SM_LN2G = 9216, SM_LN2B = 10240, SM_PER_LAYER = 11264;
constexpr size_t WS_SM = WS_MM + al256((size_t)DEPTH * 4 * 128 * 64 * 4);
constexpr size_t WS_SGW = WS_SM + al256((size_t)DEPTH * SM_PER_LAYER * 4);
constexpr size_t WS_SGWB = WS_SGW + al256((size_t)DEPTH * 4 * CHUNK * CHUNK * 4);
constexpr size_t WS_MMT = WS_SGWB + al256((size_t)DEPTH * 4 * CHUNK * CHUNK * 2);
constexpr size_t WS_WG = WS_MMT + al256((size_t)DEPTH * 4 * 64 * 128 * 2);
constexpr size_t WS_WIN = WS_WG + al256((size_t)2 * DEPTH * 2 * 8 * 64 * 64 * 2);
constexpr size_t WS_WOUT = WS_WIN + al256((size_t)DEPTH * DIN * D * 2);
constexpr size_t WS_WUP = WS_WOUT + al256((size_t)DEPTH * D * D * 2);
constexpr size_t WS_WDN = WS_WUP + al256((size_t)DEPTH * 2 * DFF * D * 2);
constexpr size_t WS_XN = WS_WDN + al256((size_t)DEPTH * D * DFF * 2);
constexpr size_t WS_GT = WS_XN;
constexpr size_t WS_V = WS_XN + (size_t)NTOK * 512 * 2;
constexpr size_t WS_P = WS_XN + al256((size_t)NTOK * D * 2);
constexpr size_t WS_Y = WS_P + (size_t)NTOK * DIN * 2;
constexpr size_t WS_H = WS_P;
constexpr size_t WS_HF = WS_Y + al256((size_t)NTOK * D * 2);
constexpr size_t WS_HB = WS_HF + al256((size_t)NTOK * DA * 2);
constexpr size_t WS_AF = WS_HB + al256((size_t)NTOK * DA * 2);
constexpr size_t WS_AB = WS_AF + al256((size_t)NTOK * DA * 2);
constexpr size_t WS_TA = WS_AB + al256((size_t)NTOK * DA * 2);
constexpr size_t WS_CARRY = WS_TA + al256((size_t)128 * 64 * 2);
constexpr size_t WS_BAR = WS_CARRY + al256((size_t)NCHUNK * 2 * DA * 4);
constexpr size_t WS_END = WS_BAR + al256((size_t)3456 * 4);
static_assert((size_t)NTOK * DFF * 2 == (size_t)NTOK * DIN * 2 + (size_t)NTOK * D * 2, "H overlays exactly P + Y");
constexpr int LDS_BYTES = 147456;
constexpr int NTHR = 512, NWAVE = 8;

struct Params { const float* in[25]; float* out; unsigned char* ws; int ph_lo, ph_hi, dup_k, dup_n; };
enum { I_X = 0, I_C, I_CTX, I_CCTX, I_WMOD, I_BMOD, I_WIN, I_CONVW, I_CONVB, I_WA, I_BA, I_WX, I_BX, I_LAM, I_SGW, I_SGB, I_FW, I_GMIX, I_WOUT, I_LN1G, I_LN1B, I_WUP, I_WDN, I_LN2G, I_LN2B };

typedef float f32x4 __attribute__((ext_vector_type(4)));
typedef unsigned u32x2 __attribute__((ext_vector_type(2)));
typedef unsigned u32x4 __attribute__((ext_vector_type(4)));
__device__ __forceinline__ int opaque_lane() { int l; asm volatile("v_mbcnt_lo_u32_b32 %0, -1, 0\n\tv_mbcnt_hi_u32_b32 %0, -1, %0" : "=v"(l)); return l; }
__device__ __forceinline__ int opaque_tid(int wv) { return (wv << 6) | opaque_lane(); }
__device__ __forceinline__ unsigned pk2(float lo, float hi) { unsigned r; asm("v_cvt_pk_bf16_f32 %0, %1, %2" : "=v"(r) : "v"(lo), "v"(hi)); return r; }
__device__ __forceinline__ float wave_sum(float v) {
#pragma unroll
    for (int o = 1; o < 64; o <<= 1) v += __shfl_xor(v, o);
    return v;
}
__device__ __forceinline__ float* xrow_ptr(const Params& p, int r) { return r < NLAT ? p.out + (size_t)r * D : (float*)(p.ws + WS_XCTX) + (size_t)(r - NLAT) * D; }
__device__ __forceinline__ int mod_row(int r) { return r < NLAT ? r / SEQ : 4; }
__device__ __forceinline__ const float* mod_ptr(const Params& p, int l, int r, int idx) { return (const float*)(p.ws + WS_MOD) + ((size_t)(l * 5 + mod_row(r)) * NMOD + idx) * D; }

struct EpiResid {
    static constexpr bool PERM = false, AFTER_DRAIN = false;
    float* xlat; float* xctx; const float* modl; int gate_idx; int dry;
    __device__ __forceinline__ void operator()(const pg8::f32x4 (&acc)[2][2][4][2], const pg8::Unit& u, int wr, int wc, int fr, int fq) const {
        const int rt = u.pm * 256;
        float* xb = rt < NLAT ? xlat + (size_t)rt * D : xctx + (size_t)(rt - NLAT) * D;
        const float* gp = modl + ((size_t)(rt < NLAT ? rt / SEQ : 4) * NMOD + gate_idx) * D;
        const int row0 = wr * 64 + fr, col0 = u.pn * 256 + wc * 32 + 4 * fq;
        pg8::f32x4 gv[2][2];
#pragma unroll
        for (int bj = 0; bj < 2; ++bj)
#pragma unroll
            for (int n = 0; n < 2; ++n) gv[bj][n] = *(const pg8::f32x4*)(gp + col0 + bj * 128 + n * 16);
#pragma unroll
        for (int ai = 0; ai < 2; ++ai)
#pragma unroll
            for (int m = 0; m < 4; ++m) { float* rowp = xb + (size_t)(row0 + ai * 128 + m * 16) * D + col0;
#pragma unroll
                for (int bj = 0; bj < 2; ++bj)
#pragma unroll
                    for (int n = 0; n < 2; ++n) { const pg8::f32x4 xv = *(const pg8::f32x4*)(rowp + bj * 128 + n * 16); const pg8::f32x4 zv = xv * ALPHA + gv[bj][n] * acc[ai][bj][m][n]; *(pg8::f32x4*)(rowp + bj * 128 + n * 16) = dry ? xv : zv; }
                asm volatile("" ::: "memory"); }
    }
};
__device__ __forceinline__ float silu_fast(float v) { return v * __builtin_amdgcn_rcpf(1.0f + __builtin_amdgcn_exp2f(-1.44269504089f * v)); }
struct EpiSwiglu {
    static constexpr bool PERM = true, AFTER_DRAIN = false;
    bf16_t* H;
    __device__ __forceinline__ void operator()(const pg8::f32x4 (&acc)[2][2][4][2], const pg8::Unit& u, int wr, int wc, int fr, int fq) const {
        const int row0 = u.pm * 256 + wr * 64 + fr, col0 = u.pn * 128 + wc * 32 + 8 * fq;
#pragma unroll
        for (int ai = 0; ai < 2; ++ai)
#pragma unroll
            for (int m = 0; m < 4; ++m) { bf16_t* rowp = H + (size_t)(row0 + ai * 128 + m * 16) * DFF + col0;
                const pg8::f32x4 g0 = acc[ai][0][m][0], g1 = acc[ai][0][m][1], u0 = acc[ai][1][m][0], u1 = acc[ai][1][m][1];
                pg8::u32x4 w;
                w.x = pk2(silu_fast(g0[0]) * u0[0], silu_fast(g0[1]) * u0[1]); w.y = pk2(silu_fast(g0[2]) * u0[2], silu_fast(g0[3]) * u0[3]);
                w.z = pk2(silu_fast(g1[0]) * u1[0], silu_fast(g1[1]) * u1[1]); w.w = pk2(silu_fast(g1[2]) * u1[2], silu_fast(g1[3]) * u1[3]);
                *(pg8::u32x4*)rowp = w; }
    }
};

__device__ __forceinline__ void transpose_item(const float* W, int K, int N, bf16_t* WT, int src_n0, int dst_n0, int k0, float* scr, int lane) {
#pragma unroll 16
    for (int i = 0; i < 32; ++i) { const int kk = 2 * i + (lane >> 5); scr[kk * 33 + (lane & 31)] = W[(size_t)(k0 + kk) * N + src_n0 + (lane & 31)]; }
    __builtin_amdgcn_s_waitcnt(0); __builtin_amdgcn_wave_barrier();
    const int c = lane & 7;
#pragma unroll
    for (int j = 0; j < 4; ++j) { const int n = (lane >> 3) + 8 * j; const float* sp = scr + (8 * c) * 33 + n;
        u32x4 o; o.x = pk2(sp[0 * 33], sp[1 * 33]); o.y = pk2(sp[2 * 33], sp[3 * 33]); o.z = pk2(sp[4 * 33], sp[5 * 33]); o.w = pk2(sp[6 * 33], sp[7 * 33]);
        *(u32x4*)(WT + (size_t)(dst_n0 + n) * K + k0 + 8 * c) = o; }
    __builtin_amdgcn_s_waitcnt(0); __builtin_amdgcn_wave_barrier();
}

__device__ __forceinline__ void phase_prologue(const Params& p, unsigned char* lds, int wv) {
    const int tid = opaque_tid(wv), lane = tid & 63, wave = tid >> 6, bid = blockIdx.x, G = gridDim.x;
    const int gtid = bid * NTHR + tid, GT_ = G * NTHR, gw = bid * NWAVE + wave, NGW = G * NWAVE;
    {
        float* sc = (float*)lds; float* red = (float*)(lds + 20480);
        bool have = false;
        for (int it = bid; it < DEPTH * 96; it += G) {
            if (!have) { for (int i = tid; i < 5 * D; i += NTHR) { const int r = i / D, k = i % D; const float v = r < 4 ? p.in[I_C][r * D + k] : p.in[I_CCTX][k]; sc[i] = silu_f(v); } have = true; }
            __syncthreads();
            const int l = it / 96, col = (it % 96) * 64 + lane;
            const float* w = p.in[I_WMOD] + ((size_t)l * D + wave * 128) * NMOD * D + col;
            float a0 = 0.f, a1 = 0.f, a2 = 0.f, a3 = 0.f, a4 = 0.f;
#pragma unroll 8
            for (int k = 0; k < 128; ++k) { const float wv = w[(size_t)k * NMOD * D]; const int kk = wave * 128 + k;
                a0 += sc[kk] * wv; a1 += sc[D + kk] * wv; a2 += sc[2 * D + kk] * wv; a3 += sc[3 * D + kk] * wv; a4 += sc[4 * D + kk] * wv; }
            red[(wave * 5 + 0) * 64 + lane] = a0; red[(wave * 5 + 1) * 64 + lane] = a1; red[(wave * 5 + 2) * 64 + lane] = a2; red[(wave * 5 + 3) * 64 + lane] = a3; red[(wave * 5 + 4) * 64 + lane] = a4;
            __syncthreads();
            if (tid < 320) { const int r = tid >> 6; float sum = 0.f;
#pragma unroll
                for (int w2 = 0; w2 < 8; ++w2) sum += red[(w2 * 5 + r) * 64 + lane];
                ((float*)(p.ws + WS_MOD))[((size_t)(l * 5 + r)) * NMOD * D + col] = sum + p.in[I_BMOD][(size_t)l * NMOD * D + col]; }
            __syncthreads();
        }
        __syncthreads();
    }
    {
        float* scr = (float*)(lds + 32768) + wave * (64 * 33);
        constexpr int I_IN = 16 * 56, I_OUT = 16 * 32, I_UP = 16 * 176, I_DN = 44 * 32, I_L = I_IN + I_OUT + I_UP + I_DN;
        for (int it = gw; it < DEPTH * I_L; it += NGW) {
            const int l = it / I_L; int r = it % I_L;
            if (r < I_IN) { const int kb = r / 56, nb = r % 56; transpose_item(p.in[I_WIN] + (size_t)l * D * DIN, D, DIN, (bf16_t*)(p.ws + WS_WIN) + (size_t)l * DIN * D, nb * 32, nb * 32, kb * 64, scr, lane); continue; }
            r -= I_IN;
            if (r < I_OUT) { const int kb = r / 32, nb = r % 32; transpose_item(p.in[I_WOUT] + (size_t)l * D * D, D, D, (bf16_t*)(p.ws + WS_WOUT) + (size_t)l * D * D, nb * 32, nb * 32, kb * 64, scr, lane); continue; }
            r -= I_OUT;
            if (r < I_UP) { const int kb = r / 176, nb = r % 176; const int sn = nb * 32; const int isup = sn >= DFF ? 1 : 0; const int sj = sn - isup * DFF; const int dn = (sj / 128) * 256 + isup * 128 + (sj % 128);
                transpose_item(p.in[I_WUP] + (size_t)l * D * 2 * DFF, D, 2 * DFF, (bf16_t*)(p.ws + WS_WUP) + (size_t)l * 2 * DFF * D, sn, dn, kb * 64, scr, lane); continue; }
            r -= I_UP;
            { const int kb = r / 32, nb = r % 32; transpose_item(p.in[I_WDN] + (size_t)l * DFF * D, DFF, D, (bf16_t*)(p.ws + WS_WDN) + (size_t)l * D * DFF, nb * 32, nb * 32, kb * 64, scr, lane); }
        }
    }
    float* tab = (float*)(p.ws + WS_TAB);
    for (int j = gtid; j < 8192; j += GT_) { tab[j] = cospif((float)j / 4096.0f); tab[8192 + j] = sinpif((float)j / 4096.0f); }
    { bf16_t* TA = (bf16_t*)(p.ws + WS_TA);
      for (int i = gtid; i < 128 * 64; i += GT_) { const int l1 = i & 63, m = i >> 6, k1 = m >> 1, comp = m & 1; const float a = (float)((k1 * l1) & 63) / 32.0f; TA[i] = f2bf(comp ? -sinpif(a) : cospif(a)); } }
    bf16_t* T = (bf16_t*)(p.ws + WS_T);
    for (int i = gtid; i < 256 * 256; i += GT_) { const int m = i >> 8, kk = i & 255, k2 = m & 127, co = m >> 7, l2 = kk >> 1, ci = kk & 1; const float a = (float)((k2 * l2) & 127) / 64.0f;
        const float cv = cospif(a), sv = sinpif(a); T[i] = f2bf(co == 0 ? (ci == 0 ? cv : sv) : (ci == 0 ? -sv : cv)); }
    { bf16_t* WG = (bf16_t*)(p.ws + WS_WG);
      for (int i = gtid; i < 2 * DEPTH * 2 * 8 * 64 * 64; i += GT_) { const int c = i & 63, e = (i >> 6) & 63, ldh = (i >> 12) & 31, gsel = i >> 17;
          const float* src = (gsel ? p.in[I_WX] : p.in[I_WA]) + ((size_t)ldh * 64 + c) * 64 + e; WG[i] = f2bf(*src); } }
    { float* SM = (float*)(p.ws + WS_SM);
      for (int i = gtid; i < DEPTH * SM_PER_LAYER; i += GT_) { const int l = i / SM_PER_LAYER, o = i % SM_PER_LAYER; float v;
          if (o < SM_CONVB) v = p.in[I_CONVW][l * 2048 + o];
          else if (o < SM_BA) v = p.in[I_CONVB][l * 512 + o - SM_CONVB];
          else if (o < SM_BX) v = p.in[I_BA][l * 1024 + o - SM_BA];
          else if (o < SM_SP8) v = p.in[I_BX][l * 1024 + o - SM_BX];
          else if (o < SM_SGB) v = -8.0f * log1pf(expf(-p.in[I_LAM][l * 1024 + o - SM_SP8]));
          else if (o < SM_GMIX) v = p.in[I_SGB][l * 512 + o - SM_SGB];
          else if (o < SM_LN1G) v = p.in[I_GMIX][l * 1024 + o - SM_GMIX];
          else if (o < SM_LN1B) v = p.in[I_LN1G][l * 1024 + o - SM_LN1G];
          else if (o < SM_LN2G) v = p.in[I_LN1B][l * 1024 + o - SM_LN1B];
          else if (o < SM_LN2B) v = p.in[I_LN2G][l * 1024 + o - SM_LN2G];
          else v = p.in[I_LN2B][l * 1024 + o - SM_LN2B];
          SM[i] = v; }
      bf16_t* SGWB = (bf16_t*)(p.ws + WS_SGWB);
      for (int i = gtid; i < DEPTH * 4 * CHUNK * CHUNK; i += GT_) SGWB[i] = f2bf(p.in[I_SGW][i]);
      bf16_t* MMT = (bf16_t*)(p.ws + WS_MMT);
      for (int i = gtid; i < DEPTH * 4 * 64 * 128; i += GT_) { const int j = i & 127, e = (i >> 7) & 63, lh = i >> 13; const int cc = j >> 1, comp = j & 1;
          const float* wf = p.in[I_FW] + ((size_t)lh * 64) * 64 + e; float sum = 0.f;
          for (int m = 0; m < 64; ++m) { const float a = (float)((cc * m) & 63) / 32.0f; sum += (comp ? sinpif(a) : cospif(a)) * wf[m * 64]; }
          MMT[i] = f2bf(sum); } }
}

__device__ __forceinline__ void ln_stats(f32x4 (&v)[4], float& rstd) {
    float s = 0.f;
#pragma unroll
    for (int j = 0; j < 4; ++j) s += (v[j][0] + v[j][1]) + (v[j][2] + v[j][3]);
    const float mean = wave_sum(s) * (1.0f / D); float q = 0.f;
#pragma unroll
    for (int j = 0; j < 4; ++j) { v[j] = v[j] - mean; q += (v[j][0] * v[j][0] + v[j][1] * v[j][1]) + (v[j][2] * v[j][2] + v[j][3] * v[j][3]); }
    rstd = rsqrtf(wave_sum(q) * (1.0f / D) + LN_EPS);
}
__device__ __forceinline__ void lnmod_store(const Params& p, f32x4 (&v)[4], int l, int r, int shift_idx, int scale_idx, int lane) {
    float rstd; ln_stats(v, rstd);
    const f32x4* sh = (const f32x4*)mod_ptr(p, l, r, shift_idx) + lane; const f32x4* sc = (const f32x4*)mod_ptr(p, l, r, scale_idx) + lane;
    u32x2* o = (u32x2*)((bf16_t*)(p.ws + WS_XN) + (size_t)r * D) + lane;
#pragma unroll
    for (int j = 0; j < 4; ++j) { const f32x4 a = sc[64 * j], b = sh[64 * j]; f32x4 y = v[j] * rstd * (a + 1.0f) + b; u32x2 w; w.x = pk2(y[0], y[1]); w.y = pk2(y[2], y[3]); o[64 * j] = w; }
}
__device__ __forceinline__ void phase_lnmod0(const Params& p, int wv) {
    const int lane = opaque_lane(), gw = blockIdx.x * NWAVE + wv, NGW = gridDim.x * NWAVE;
    for (int t = gw; t < SEQ; t += NGW) {
        f32x4 pe[4];
#pragma unroll
        for (int k = 0; k < 4; ++k) { const float freq = exp2f(-(float)(4 * lane + k) * (13.287712379549449f / 256.0f)) * 0.3183098861837907f; const float ar = (float)(t / 64) * freq, ac = (float)(t % 64) * freq;
            pe[0][k] = sinpif(ar); pe[1][k] = cospif(ar); pe[2][k] = sinpif(ac); pe[3][k] = cospif(ac); }
        f32x4 xa[NB][4];
#pragma unroll
        for (int b = 0; b < NB; ++b) { const f32x4* xr = (const f32x4*)(p.in[I_X] + (size_t)(b * SEQ + t) * D) + lane;
#pragma unroll
            for (int j = 0; j < 4; ++j) xa[b][j] = xr[64 * j]; }
#pragma unroll
        for (int b = 0; b < NB; ++b) { const int r = b * SEQ + t; f32x4* xo = (f32x4*)(p.out + (size_t)r * D) + lane; f32x4 v[4];
#pragma unroll
            for (int j = 0; j < 4; ++j) { v[j] = xa[b][j] + pe[j]; xo[64 * j] = v[j]; }
            lnmod_store(p, v, 0, r, 0, 1, lane); }
    }
    for (int rc = gw; rc < NCTX; rc += NGW) { const int r = NLAT + rc; const f32x4* xr = (const f32x4*)(p.in[I_CTX] + (size_t)rc * D) + lane; f32x4* xo = (f32x4*)(p.ws + WS_XCTX + (size_t)rc * D * 4) + lane; f32x4 v[4];
#pragma unroll
        for (int j = 0; j < 4; ++j) { v[j] = xr[64 * j]; xo[64 * j] = v[j]; }
        lnmod_store(p, v, 0, r, 0, 1, lane); }
}
__device__ __forceinline__ void wave_sum2(float& a, float& b) {
#pragma unroll
    for (int o = 1; o < 64; o <<= 1) { const float ta = __shfl_xor(a, o), tb = __shfl_xor(b, o); a += ta; b += tb; }
}
__device__ __forceinline__ void phase_ln(const Params& p, int nrows, const float* g, const float* b, int l, int gate_idx, int nl, int shift_idx, int scale_idx, int wv, int dry) {
    const int lane = opaque_lane(), gw = blockIdx.x * NWAVE + wv, NGW = gridDim.x * NWAVE;
    const bf16_t* T = (const bf16_t*)(p.ws + WS_XN);
    f32x4 xn_[2][4]; u32x2 tn_[2][4];
#pragma unroll
    for (int u = 0; u < 2; ++u) { const int r = gw + u * NGW; const int rr = r < nrows ? r : gw; const f32x4* xr = (const f32x4*)xrow_ptr(p, rr) + lane; const u32x2* tr = (const u32x2*)(T + (size_t)rr * D) + lane;
#pragma unroll
        for (int j = 0; j < 4; ++j) { xn_[u][j] = __builtin_nontemporal_load(xr + 64 * j); tn_[u][j] = __builtin_nontemporal_load(tr + 64 * j); } }
    for (int r0 = gw; r0 < nrows; r0 += 2 * NGW) {
        const int r1 = r0 + NGW; const bool ok1 = r1 < nrows; const int rr[2] = {r0, ok1 ? r1 : r0};
        f32x4 v[2][4], x0[2][4]; u32x2 t[2][4];
#pragma unroll
        for (int u = 0; u < 2; ++u)
#pragma unroll
            for (int j = 0; j < 4; ++j) { x0[u][j] = xn_[u][j]; t[u][j] = tn_[u][j]; }
        f32x4 gv[2][4];
#pragma unroll
        for (int u = 0; u < 2; ++u) { const f32x4* gt = (const f32x4*)mod_ptr(p, l, rr[u], gate_idx) + lane;
#pragma unroll
            for (int j = 0; j < 4; ++j) gv[u][j] = gt[64 * j]; }
#pragma unroll
        for (int u = 0; u < 2; ++u) { const int rn = r0 + (2 + u) * NGW; const int rq = rn < nrows ? rn : gw; const f32x4* xr = (const f32x4*)xrow_ptr(p, rq) + lane; const u32x2* tr = (const u32x2*)(T + (size_t)rq * D) + lane;
#pragma unroll
            for (int j = 0; j < 4; ++j) { xn_[u][j] = __builtin_nontemporal_load(xr + 64 * j); tn_[u][j] = __builtin_nontemporal_load(tr + 64 * j); } }
        f32x4 gg[4], bb[4];
#pragma unroll
        for (int j = 0; j < 4; ++j) { gg[j] = ((const f32x4*)g)[lane + 64 * j]; bb[j] = ((const f32x4*)b)[lane + 64 * j]; }
        float s[2];
#pragma unroll
        for (int u = 0; u < 2; ++u) { s[u] = 0.f;
#pragma unroll
            for (int j = 0; j < 4; ++j) { f32x4 tv; tv[0] = __builtin_bit_cast(float, t[u][j].x << 16); tv[1] = __builtin_bit_cast(float, t[u][j].x & 0xffff0000u); tv[2] = __builtin_bit_cast(float, t[u][j].y << 16); tv[3] = __builtin_bit_cast(float, t[u][j].y & 0xffff0000u);
                v[u][j] = x0[u][j] * ALPHA + gv[u][j] * tv; s[u] += (v[u][j][0] + v[u][j][1]) + (v[u][j][2] + v[u][j][3]); } }
        f32x4 shv[2][4], scv[2][4];
        if (nl >= 0) {
#pragma unroll
            for (int u = 0; u < 2; ++u) { const f32x4* sh = (const f32x4*)mod_ptr(p, nl, rr[u], shift_idx) + lane; const f32x4* sc = (const f32x4*)mod_ptr(p, nl, rr[u], scale_idx) + lane;
#pragma unroll
                for (int j = 0; j < 4; ++j) { shv[u][j] = sh[64 * j]; scv[u][j] = sc[64 * j]; } } }
        wave_sum2(s[0], s[1]);
        float q[2];
#pragma unroll
        for (int u = 0; u < 2; ++u) { const float mean = s[u] * (1.0f / D); q[u] = 0.f;
#pragma unroll
            for (int j = 0; j < 4; ++j) { v[u][j] = v[u][j] - mean; q[u] += (v[u][j][0] * v[u][j][0] + v[u][j][1] * v[u][j][1]) + (v[u][j][2] * v[u][j][2] + v[u][j][3] * v[u][j][3]); } }
        wave_sum2(q[0], q[1]);
#pragma unroll
        for (int u = 0; u < 2; ++u) { const float rstd = rsqrtf(q[u] * (1.0f / D) + LN_EPS); f32x4* xr = (f32x4*)xrow_ptr(p, rr[u]) + lane;
            if (u == 0 || ok1) {
#pragma unroll
                for (int j = 0; j < 4; ++j) { v[u][j] = v[u][j] * rstd * gg[j] + bb[j]; __builtin_nontemporal_store(v[u][j], xr + 64 * j); } } }
        if (nl >= 0) {
#pragma unroll
            for (int u = 0; u < 2; ++u) { s[u] = 0.f;
#pragma unroll
                for (int j = 0; j < 4; ++j) s[u] += (v[u][j][0] + v[u][j][1]) + (v[u][j][2] + v[u][j][3]); }
            wave_sum2(s[0], s[1]);
#pragma unroll
            for (int u = 0; u < 2; ++u) { const float mean = s[u] * (1.0f / D); q[u] = 0.f;
#pragma unroll
                for (int j = 0; j < 4; ++j) { v[u][j] = v[u][j] - mean; q[u] += (v[u][j][0] * v[u][j][0] + v[u][j][1] * v[u][j][1]) + (v[u][j][2] * v[u][j][2] + v[u][j][3] * v[u][j][3]); } }
            wave_sum2(q[0], q[1]);
#pragma unroll
            for (int u = 0; u < 2; ++u) { const float rstd = rsqrtf(q[u] * (1.0f / D) + LN_EPS); u32x2* o = (u32x2*)((bf16_t*)(p.ws + WS_XN) + (size_t)rr[u] * D) + lane;
                if (u == 0 || ok1) {
#pragma unroll
                    for (int j = 0; j < 4; ++j) { const f32x4 y = v[u][j] * rstd * (scv[u][j] + 1.0f) + shv[u][j]; u32x2 w; w.x = pk2(y[0], y[1]); w.y = pk2(y[2], y[3]); o[64 * j] = w; } } }
        }
    }
}

__device__ __forceinline__ void chunk_info(int cidx, int& r0, int& s0, int& L) {
    r0 = cidx * CHUNK;
    if (cidx < NLAT / CHUNK) { s0 = (cidx >> 6) * SEQ; L = SEQ; } else { s0 = NLAT + ((cidx - NLAT / CHUNK) >> 1) * CTX; L = CTX; }
}
__device__ __forceinline__ float sigmoid_fast(float v) { return __builtin_amdgcn_rcpf(1.0f + __builtin_amdgcn_exp2f(-1.44269504089f * v)); }
__device__ __forceinline__ float gelu_fast(float v) {
    const float av = fabsf(v), t = __builtin_amdgcn_rcpf(av * 0.2316418882f + 1.0f);
    float q = t * 0.5307027145f + (-0.7265760135f); q = q * t + 0.7107068705f; q = q * t + (-0.142248368f); q = q * t + 0.127414796f; q = q * t;
    const float e = __builtin_amdgcn_exp2f((v * v) * (-0.72134752044f)); const float m = v * (q * e);
    return v < 0.f ? m : v - m;
}

template <int DIR>
__device__ __forceinline__ void scan_item(const Params& p, int l, int cidx, int h, float* wl, int lane) {
    int r0, s0, L; chunk_info(cidx, r0, s0, L); const int t0 = r0 - s0;
    const int ch = h * 64 + lane;
    const bf16_t* P = (const bf16_t*)(p.ws + WS_P);
    const float* sm = (const float*)(p.ws + WS_SM) + (size_t)l * SM_PER_LAYER;
    const float* cw = sm + SM_CONVW + ch; const float cw0 = cw[0], cw1 = cw[DA], cw2 = cw[2 * DA], cw3 = cw[3 * DA], cb = sm[SM_CONVB + ch];
    const float ba = sm[SM_BA + DIR * DA + ch], bx = sm[SM_BX + DIR * DA + ch], sp8 = sm[SM_SP8 + DIR * DA + ch];
    pg8::bf16x8 wfa[4][2], wfx[4][2];
    { const bf16_t* wga = (const bf16_t*)(p.ws + WS_WG) + (((size_t)(l * 2 + DIR) * 8 + h) * 64) * 64; const bf16_t* wgx = wga + (size_t)DEPTH * 2 * 8 * 64 * 64;
#pragma unroll
      for (int nt = 0; nt < 4; ++nt)
#pragma unroll
          for (int ks = 0; ks < 2; ++ks) { const int o = (16 * nt + (lane & 15)) * 64 + 32 * ks + 8 * (lane >> 4); wfa[nt][ks] = *(const pg8::bf16x8*)(wga + o); wfx[nt][ks] = *(const pg8::bf16x8*)(wgx + o); } }
    float* zaL = wl + 16 * 68; float* zxL = wl + 32 * 68;
    float* agg = (float*)(p.ws + WS_AGG);
    float hst = 0.f, Ap = 1.f;
    const __amdgpu_buffer_rsrc_t hrs = __builtin_amdgcn_make_buffer_rsrc(p.ws, 0, 0x7fffffff, 0x00020000); const unsigned hbase = (unsigned)(DIR == 0 ? WS_HF : WS_AF) + (unsigned)(r0 * DA + ch) * 4u;
    bf16_t xn[19];
    { const int s = DIR ? 7 : 0; const int rb = r0 + 16 * s - 2, tb = t0 + 16 * s - 2;
#pragma unroll
      for (int i = 0; i < 19; ++i) { const int t = tb + i; xn[i] = (t >= 0 && t < L) ? P[(size_t)(rb + i) * DIN + ch] : (bf16_t)0; } }
#pragma unroll 1
    for (int si = 0; si < 8; ++si) {
        const int s = DIR ? 7 - si : si;
        float xw[19];
#pragma unroll
        for (int i = 0; i < 19; ++i) xw[i] = bf2f(xn[i]);
        if (si < 7) { const int s2 = DIR ? 6 - si : si + 1; const int rb = r0 + 16 * s2 - 2, tb = t0 + 16 * s2 - 2;
#pragma unroll
            for (int i = 0; i < 19; ++i) { const int t = tb + i; xn[i] = (t >= 0 && t < L) ? P[(size_t)(rb + i) * DIN + ch] : (bf16_t)0; } }
#pragma unroll
        for (int tt = 0; tt < 16; ++tt) wl[tt * 68 + lane] = cb + cw0 * xw[tt] + cw1 * xw[tt + 1] + cw2 * xw[tt + 2] + cw3 * xw[tt + 3];
        asm volatile("s_waitcnt lgkmcnt(0)" ::: "memory");
        {
            pg8::bf16x8 af[2];
#pragma unroll
            for (int ks = 0; ks < 2; ++ks) { const float* xp = wl + (lane & 15) * 68 + 32 * ks + 8 * (lane >> 4); const f32x4 x0 = *(const f32x4*)xp, x1 = *(const f32x4*)(xp + 4);
                const unsigned w0 = pk2(x0[0], x0[1]), w1 = pk2(x0[2], x0[3]), w2 = pk2(x1[0], x1[1]), w3 = pk2(x1[2], x1[3]);
                u32x4 t; t.x = w0; t.y = w1; t.z = w2; t.w = w3; af[ks] = __builtin_bit_cast(pg8::bf16x8, t); }
#pragma unroll
            for (int nt = 0; nt < 4; ++nt) { pg8::f32x4 ca = {0.f, 0.f, 0.f, 0.f}, cx = {0.f, 0.f, 0.f, 0.f};
#pragma unroll
                for (int ks = 0; ks < 2; ++ks) { ca = __builtin_amdgcn_mfma_f32_16x16x32_bf16(af[ks], wfa[nt][ks], ca, 0, 0, 0); cx = __builtin_amdgcn_mfma_f32_16x16x32_bf16(af[ks], wfx[nt][ks], cx, 0, 0, 0); }
#pragma unroll
                for (int rg_ = 0; rg_ < 4; ++rg_) { const int o = (4 * (lane >> 4) + rg_) * 68 + 16 * nt + (lane & 15); zaL[o] = ca[rg_]; zxL[o] = cx[rg_]; } }
        }
        asm volatile("s_waitcnt lgkmcnt(0)" ::: "memory");
#pragma unroll
        for (int ti = 0; ti < 16; ti += 2) {
            typedef float f32x2 __attribute__((ext_vector_type(2)));
            const int ta_ = DIR ? 15 - ti : ti, tb_ = DIR ? 14 - ti : ti + 1;
            const f32x2 za = (f32x2){zaL[ta_ * 68 + lane], zaL[tb_ * 68 + lane]} + ba, zx = (f32x2){zxL[ta_ * 68 + lane], zxL[tb_ * 68 + lane]} + bx;
            const f32x2 xo = (f32x2){wl[ta_ * 68 + lane], wl[tb_ * 68 + lane]};
            const f32x2 ea = za * (-1.44269504089f), ex = zx * (-1.44269504089f);
            f32x2 da, dx; da.x = __builtin_amdgcn_exp2f(ea.x); da.y = __builtin_amdgcn_exp2f(ea.y); dx.x = __builtin_amdgcn_exp2f(ex.x); dx.y = __builtin_amdgcn_exp2f(ex.y);
            da = da + 1.0f; dx = dx + 1.0f;
            f32x2 rg, ig; rg.x = __builtin_amdgcn_rcpf(da.x); rg.y = __builtin_amdgcn_rcpf(da.y); ig.x = __builtin_amdgcn_rcpf(dx.x); ig.y = __builtin_amdgcn_rcpf(dx.y);
            const f32x2 la = rg * (sp8 * 1.44269504089f);
            f32x2 a; a.x = __builtin_amdgcn_exp2f(la.x); a.y = __builtin_amdgcn_exp2f(la.y);
            const f32x2 om = 1.0f - a * a;
            f32x2 sq; sq.x = __builtin_amdgcn_sqrtf(om.x); sq.y = __builtin_amdgcn_sqrtf(om.y);
            const f32x2 u = sq * (ig * xo);
            hst = a.x * hst + u.x; Ap *= a.x; __builtin_amdgcn_raw_buffer_store_b32(pg8::cvt_pk_bf16(hst, Ap), hrs, (int)(hbase + (unsigned)(16 * s * DA) * 4u), ta_ * DA * 4, 0);
            hst = a.y * hst + u.y; Ap *= a.y; __builtin_amdgcn_raw_buffer_store_b32(pg8::cvt_pk_bf16(hst, Ap), hrs, (int)(hbase + (unsigned)(16 * s * DA) * 4u), tb_ * DA * 4, 0);
        }
        asm volatile("s_waitcnt lgkmcnt(0)" ::: "memory");
    }
    { float* a = agg + ((size_t)cidx * 2 + DIR) * 2 * DA + ch; a[0] = Ap; a[DA] = hst; }
}

__device__ __forceinline__ void phase_mix1(const Params& p, int l, unsigned char* lds, int wv, int mode) {
    const int tid = opaque_tid(wv), lane = tid & 63, wave = tid >> 6, bid = blockIdx.x, G = gridDim.x;
    const int gw = bid * NWAVE + wave, NGW = G * NWAVE; const bool last = (l == DEPTH - 1);
    const bf16_t* P = (const bf16_t*)(p.ws + WS_P);
    if (mode & 1) { float* wl = (float*)lds + wave * 3264;
      const int nfull = (NCHUNK * 16 / NGW) * NGW, nextra = NCHUNK * 16 - nfull, estep = NGW / (nextra > 0 ? nextra : 1);
      for (int k = 0; k <= NCHUNK * 16 / NGW; ++k) { int it;
          if (k < NCHUNK * 16 / NGW) it = gw + k * NGW; else { if (nextra == 0 || gw % estep != 0 || gw / estep >= nextra) break; it = nfull + gw / estep; }
          const int cidx = it >> 4, d = (it >> 3) & 1, h = it & 7;
          if (d == 0) scan_item<0>(p, l, cidx, h, wl, lane); else scan_item<1>(p, l, cidx, h, wl, lane); } }
    __syncthreads();
    const float* tab = (const float*)(p.ws + WS_TAB); bf16_t* GT = (bf16_t*)(p.ws + WS_GT);
    if (!(mode & 2)) return;
    { bf16_t* zt = (bf16_t*)lds; constexpr int ZK = 72;
      const bf16_t* TA = (const bf16_t*)(p.ws + WS_TA);
      for (int it = bid; it < NB * 64; it += G) { const int b = it >> 6, lb = (it >> 2) & 15, cq = it & 3;
          { const int l1 = tid >> 3, l2i = tid & 7; const u32x4* src = (const u32x4*)(P + (size_t)(b * SEQ + l1 * 128 + lb * 8 + l2i) * DIN + 2 * DA + 2 * DB + cq * 64);
            u32x4 w[8];
#pragma unroll
            for (int j = 0; j < 8; ++j) w[j] = src[j];
#pragma unroll
            for (int j = 0; j < 8; ++j) { const unsigned ww[4] = {w[j].x, w[j].y, w[j].z, w[j].w};
#pragma unroll
                for (int e = 0; e < 4; ++e) { const int chl = j * 8 + 2 * e; zt[(chl * 8 + l2i) * ZK + l1] = (bf16_t)(ww[e] & 0xffffu); zt[((chl + 1) * 8 + l2i) * ZK + l1] = (bf16_t)(ww[e] >> 16); } } }
          __syncthreads();
          { int ln = lane; asm volatile("" : "+v"(ln)); const int fr = ln & 15, fq = ln >> 4;
            pg8::bf16x8 ta[8][2];
#pragma unroll
            for (int mt = 0; mt < 8; ++mt)
#pragma unroll
                for (int ks = 0; ks < 2; ++ks) ta[mt][ks] = *(const pg8::bf16x8*)(TA + (16 * mt + fr) * 64 + 32 * ks + 8 * fq);
#pragma unroll 1
            for (int nt = 0; nt < 4; ++nt) { const int n0 = 64 * wave + 16 * nt;
                const pg8::bf16x8 b0 = *(const pg8::bf16x8*)(zt + (n0 + fr) * ZK + 8 * fq), b1 = *(const pg8::bf16x8*)(zt + (n0 + fr) * ZK + 32 + 8 * fq);
                const int chl = (n0 + fr) >> 3, l2 = lb * 8 + (fr & 7);
                bf16_t* gbase = GT + ((size_t)(b * 64) * 256 + cq * 64 + chl) * 256 + 2 * l2;
#pragma unroll
                for (int mt = 0; mt < 8; ++mt) { pg8::f32x4 acc = {0.f, 0.f, 0.f, 0.f};
                    acc = __builtin_amdgcn_mfma_f32_16x16x32_bf16(ta[mt][0], b0, acc, 0, 0, 0); acc = __builtin_amdgcn_mfma_f32_16x16x32_bf16(ta[mt][1], b1, acc, 0, 0, 0);
#pragma unroll
                    for (int pr = 0; pr < 2; ++pr) { const int k1 = 8 * mt + 2 * fq + pr; const float gr = acc[2 * pr], gi = acc[2 * pr + 1]; const int ix = k1 * l2;
                        const float cs = tab[ix], sn = tab[8192 + ix];
                        *(unsigned*)(gbase + (size_t)k1 * 256 * 256) = pk2(gr * cs + gi * sn, gi * cs - gr * sn); } } } }
          __syncthreads();
      } }
    if (!last) {
        for (int i = bid * NTHR + tid; i < NB * 128 * 256; i += G * NTHR) { const int ch = i & 255, l2 = (i >> 8) & 127, b = i >> 15;
            const float z0 = bf2f(P[(size_t)(NLAT + b * CTX + l2) * DIN + 2 * DA + 2 * DB + ch]), z1 = bf2f(P[(size_t)(NLAT + b * CTX + 128 + l2) * DIN + 2 * DA + 2 * DB + ch]);
            const float g0 = z0 + z1, g1 = z0 - z1; const float c1 = tab[l2 * 32], s1 = tab[8192 + l2 * 32];
            *(unsigned*)(GT + ((size_t)((256 + b * 2 + 0) * 256 + ch)) * 256 + 2 * l2) = pk2(g0, 0.f);
            *(unsigned*)(GT + ((size_t)((256 + b * 2 + 1) * 256 + ch)) * 256 + 2 * l2) = pk2(g1 * c1, -g1 * s1); }
    }
}


__device__ __forceinline__ void phase_carry(const Params& p, int wv) {
    const int G = gridDim.x, k = (int)blockIdx.x - (G - 8); if (k < 0) return;
    const int ch = opaque_tid(wv), b = k >> 1, d = k & 1;
    const float* agg = (const float*)(p.ws + WS_AGG); float* car = (float*)(p.ws + WS_CARRY);
    const int cbase = NLAT / CHUNK + 2 * b, lbase = b * 64; float h = 0.f;
    if (d == 0) {
#pragma unroll
        for (int j = 0; j < 2; ++j) { const int c = cbase + j; const float* a = agg + ((size_t)c * 2 + 0) * 2 * DA + ch; car[((size_t)c * 2 + 0) * DA + ch] = h; h = a[0] * h + a[DA]; }
#pragma unroll 32
        for (int j = 0; j < 64; ++j) { const int c = lbase + j; const float* a = agg + ((size_t)c * 2 + 0) * 2 * DA + ch; car[((size_t)c * 2 + 0) * DA + ch] = h; h = a[0] * h + a[DA]; }
    } else {
#pragma unroll
        for (int j = 1; j >= 0; --j) { const int c = cbase + j; const float* a = agg + ((size_t)c * 2 + 1) * 2 * DA + ch; car[((size_t)c * 2 + 1) * DA + ch] = h; h = a[0] * h + a[DA]; }
#pragma unroll 32
        for (int j = 63; j >= 0; --j) { const int c = lbase + j; const float* a = agg + ((size_t)c * 2 + 1) * 2 * DA + ch; car[((size_t)c * 2 + 1) * DA + ch] = h; h = a[0] * h + a[DA]; }
    }
}

struct EpiDftB {
    static constexpr bool PERM = false, AFTER_DRAIN = false;
    bf16_t* V;
    __device__ __forceinline__ void operator()(const pg8::f32x4 (&acc)[2][2][4][2], const pg8::Unit& u, int wr, int wc, int fr, int fq) const {
        const int item = u.pn; int tok0, n1; float scale;
        if (item < 256) { tok0 = (item >> 6) * SEQ + (item & 63); n1 = 64; scale = 0.00138106793f;   }
        else { const int j = item - 256; tok0 = NLAT + (j >> 1) * CTX + (j & 1); n1 = 2; scale = 0.0078125f;   }
        const int ch0 = wc * 32 + 4 * fq;
#pragma unroll
        for (int m = 0; m < 4; ++m) { const int k2 = wr * 64 + m * 16 + fr; bf16_t* rowp = V + (size_t)(tok0 + n1 * k2) * 512 + 2 * ch0;
#pragma unroll
            for (int bj = 0; bj < 2; ++bj)
#pragma unroll
                for (int n = 0; n < 2; ++n) { const pg8::f32x4 re = acc[0][bj][m][n] * scale, im = acc[1][bj][m][n] * scale;
                    pg8::u32x4 w; w.x = pk2(re[0], im[0]); w.y = pk2(re[1], im[1]); w.z = pk2(re[2], im[2]); w.w = pk2(re[3], im[3]);
                    *(pg8::u32x4*)(rowp + 2 * (bj * 128 + n * 16)) = w; } }
    }
};

__device__ __forceinline__ void phase_mix3(const Params& p, int l, unsigned char* lds, int wv, int mode) {
    const int tid = opaque_tid(wv), lane = tid & 63, wave = tid >> 6, bid = blockIdx.x, G = gridDim.x;
    const bool last = (l == DEPTH - 1);
    const int nchunk = last ? NLAT / CHUNK : NCHUNK;
    constexpr int VQ = 136;
    bf16_t* vt = (bf16_t*)lds;
    bf16_t* mt = vt + 4 * 64 * VQ;
    const bf16_t* P = (const bf16_t*)(p.ws + WS_P); const unsigned* HAF = (const unsigned*)(p.ws + WS_HF); const unsigned* HAB = (const unsigned*)(p.ws + WS_AF);
    const float* car = (const float*)(p.ws + WS_CARRY);
    const bf16_t* V = (const bf16_t*)(p.ws + WS_V); bf16_t* Y = (bf16_t*)(p.ws + WS_Y);
    const bf16_t* WsB = (const bf16_t*)(p.ws + WS_SGWB) + (size_t)l * 4 * CHUNK * CHUNK; const bf16_t* MMT = (const bf16_t*)(p.ws + WS_MMT) + (size_t)l * 4 * 64 * 128;
    const float* sm = (const float*)(p.ws + WS_SM) + (size_t)l * SM_PER_LAYER; const float* gm = sm + SM_GMIX; const float* bsb = sm + SM_SGB;
    for (int i = tid; i < 4 * 64 * 16; i += NTHR) { const int row = i >> 4, c8 = (i & 15) * 8; *(u32x4*)(mt + row * VQ + c8) = *(const u32x4*)(MMT + (size_t)row * 128 + c8); }
    for (int cidx = bid; cidx < nchunk; cidx += G) {
        const int r0 = cidx * CHUNK, rw = r0 + 16 * wave;
#pragma unroll 1
        for (int pass = 0; pass < 2; ++pass) {
        if (pass == (bid & 1)) {
        pg8::bf16x8 wfr[16], vfr[16];
        { int ln = lane; asm volatile("" : "+v"(ln)); const int fr = ln & 15, fq = ln >> 4, prow = 16 * wave + fr;
#pragma unroll
          for (int h = 0; h < 4; ++h)
#pragma unroll
              for (int ks = 0; ks < 4; ++ks) { wfr[h * 4 + ks] = *(const pg8::bf16x8*)(WsB + ((size_t)(h * CHUNK + prow)) * CHUNK + 32 * ks + 8 * fq);
                  vfr[h * 4 + ks] = *(const pg8::bf16x8*)(V + (size_t)(r0 + prow) * 512 + h * 128 + 32 * ks + 8 * fq); } }
        if (mode & 1) { u32x2 vr[16];
#pragma unroll
          for (int i = 0; i < 16; ++i) vr[i] = *(const u32x2*)(P + (size_t)(rw + i) * DIN + 2 * DA + DB + lane * 4);
#pragma unroll
          for (int i = 0; i < 16; ++i) { float v0 = gelu_fast(__builtin_bit_cast(float, vr[i].x << 16)), v1 = gelu_fast(__builtin_bit_cast(float, vr[i].x & 0xffff0000u)), v2 = gelu_fast(__builtin_bit_cast(float, vr[i].y << 16)), v3 = gelu_fast(__builtin_bit_cast(float, vr[i].y & 0xffff0000u));
              float sm_ = (v0 + v1) + (v2 + v3); sm_ += __shfl_xor(sm_, 1); sm_ += __shfl_xor(sm_, 2); sm_ += __shfl_xor(sm_, 4); sm_ += __shfl_xor(sm_, 8);
              const float mean = sm_ * (1.0f / 64.0f); v0 -= mean; v1 -= mean; v2 -= mean; v3 -= mean;
              float q_ = (v0 * v0 + v1 * v1) + (v2 * v2 + v3 * v3); q_ += __shfl_xor(q_, 1); q_ += __shfl_xor(q_, 2); q_ += __shfl_xor(q_, 4); q_ += __shfl_xor(q_, 8);
              const float rstd = rsqrtf(q_ * (1.0f / 64.0f) + LN_EPS); bf16_t* vp = vt + (lane * 4) * VQ + 16 * wave + i;
              vp[0] = f2bf(v0 * rstd); vp[VQ] = f2bf(v1 * rstd); vp[2 * VQ] = f2bf(v2 * rstd); vp[3 * VQ] = f2bf(v3 * rstd); } }
        __syncthreads();
        pg8::f32x4 acc[16];
        if (mode & 2) { int ln = lane; asm volatile("" : "+v"(ln)); const int fr = ln & 15, fq = ln >> 4, prow = 16 * wave + fr; bf16_t* yr = Y + (size_t)(r0 + prow) * D;
#pragma unroll
        for (int i = 0; i < 16; ++i) acc[i] = (pg8::f32x4){0.f, 0.f, 0.f, 0.f};
#pragma unroll
        for (int h = 0; h < 4; ++h)
#pragma unroll
            for (int ks = 0; ks < 4; ++ks) { const pg8::bf16x8 bfr = wfr[h * 4 + ks];
#pragma unroll
                for (int nt = 0; nt < 4; ++nt) { const pg8::bf16x8 afr = *(const pg8::bf16x8*)(vt + (h * 64 + 16 * nt + fr) * VQ + 32 * ks + 8 * fq);
                    acc[h * 4 + nt] = __builtin_amdgcn_mfma_f32_16x16x32_bf16(afr, bfr, acc[h * 4 + nt], 0, 0, 0); }
                if (ks == 3) asm volatile("" ::: "memory"); }
        { float s2 = 0.f;
#pragma unroll
          for (int h = 0; h < 4; ++h) { const float bsv = bsb[h * CHUNK + prow];
#pragma unroll
              for (int nt = 0; nt < 4; ++nt) { const u32x2 uw = *(const u32x2*)(P + (size_t)(r0 + prow) * DIN + 2 * DA + h * 64 + 16 * nt + 4 * fq);
                  const float u0 = __builtin_bit_cast(float, uw.x << 16), u1 = __builtin_bit_cast(float, uw.x & 0xffff0000u), u2 = __builtin_bit_cast(float, uw.y << 16), u3 = __builtin_bit_cast(float, uw.y & 0xffff0000u);
                  pg8::f32x4 y; y[0] = gelu_fast(u0) * (acc[h * 4 + nt][0] + bsv); y[1] = gelu_fast(u1) * (acc[h * 4 + nt][1] + bsv); y[2] = gelu_fast(u2) * (acc[h * 4 + nt][2] + bsv); y[3] = gelu_fast(u3) * (acc[h * 4 + nt][3] + bsv);
                  acc[h * 4 + nt] = y; s2 += (y[0] * y[0] + y[1] * y[1]) + (y[2] * y[2] + y[3] * y[3]); } }
          s2 += __shfl_xor(s2, 16); s2 += __shfl_xor(s2, 32);
          const float rb = rsqrtf(s2 * (1.0f / DB) + LN_EPS);
#pragma unroll
          for (int i = 0; i < 16; ++i) { const int col = DA + (i >> 2) * 64 + 16 * (i & 3) + 4 * fq; const f32x4 g4 = *(const f32x4*)(gm + col);
              u32x2 o; o.x = pk2(acc[i][0] * rb * g4[0], acc[i][1] * rb * g4[1]); o.y = pk2(acc[i][2] * rb * g4[2], acc[i][3] * rb * g4[3]); *(u32x2*)(yr + col) = o; } } }
        asm volatile("" ::: "memory");
        if (mode & 4) { int ln = lane; asm volatile("" : "+v"(ln)); const int fr = ln & 15, fq = ln >> 4, prow = 16 * wave + fr; bf16_t* yr = Y + (size_t)(r0 + prow) * D;
#pragma unroll
        for (int i = 0; i < 16; ++i) acc[i] = (pg8::f32x4){0.f, 0.f, 0.f, 0.f};
#pragma unroll
        for (int h = 0; h < 4; ++h)
#pragma unroll
            for (int ks = 0; ks < 4; ++ks) { const pg8::bf16x8 bfr = vfr[h * 4 + ks];
#pragma unroll
                for (int nt = 0; nt < 4; ++nt) { const pg8::bf16x8 afr = *(const pg8::bf16x8*)(mt + (h * 64 + 16 * nt + fr) * VQ + 32 * ks + 8 * fq);
                    acc[h * 4 + nt] = __builtin_amdgcn_mfma_f32_16x16x32_bf16(afr, bfr, acc[h * 4 + nt], 0, 0, 0); }
                if (ks == 3) asm volatile("" ::: "memory"); }
        { float s2 = 0.f;
#pragma unroll
          for (int i = 0; i < 16; ++i) s2 += (acc[i][0] * acc[i][0] + acc[i][1] * acc[i][1]) + (acc[i][2] * acc[i][2] + acc[i][3] * acc[i][3]);
          s2 += __shfl_xor(s2, 16); s2 += __shfl_xor(s2, 32);
          const float rc = rsqrtf(s2 * (1.0f / DC) + LN_EPS);
#pragma unroll
          for (int i = 0; i < 16; ++i) { const int col = DA + DB + (i >> 2) * 64 + 16 * (i & 3) + 4 * fq; const f32x4 g4 = *(const f32x4*)(gm + col);
              u32x2 o; o.x = pk2(acc[i][0] * rc * g4[0], acc[i][1] * rc * g4[1]); o.y = pk2(acc[i][2] * rc * g4[2], acc[i][3] * rc * g4[3]); *(u32x2*)(yr + col) = o; } } }
        asm volatile("" ::: "memory");
        } else {
        if (mode & 8) { float cf[8], cbk[8];
#pragma unroll
          for (int k = 0; k < 8; ++k) { cf[k] = car[((size_t)cidx * 2 + 0) * DA + lane * 8 + k]; cbk[k] = car[((size_t)cidx * 2 + 1) * DA + lane * 8 + k]; }
#pragma unroll 4
        for (int i = 0; i < 16; ++i) { const int r = rw + i; float ya[8]; float sa2 = 0.f;
            const u32x4 gq = *(const u32x4*)(P + (size_t)r * DIN + DA + lane * 8);
            const u32x4 f0 = *(const u32x4*)(HAF + (size_t)r * DA + lane * 8), f1 = *(const u32x4*)(HAF + (size_t)r * DA + lane * 8 + 4), b0 = *(const u32x4*)(HAB + (size_t)r * DA + lane * 8), b1 = *(const u32x4*)(HAB + (size_t)r * DA + lane * 8 + 4);
            const unsigned gg[4] = {gq.x, gq.y, gq.z, gq.w}, ff[8] = {f0.x, f0.y, f0.z, f0.w, f1.x, f1.y, f1.z, f1.w}, bb[8] = {b0.x, b0.y, b0.z, b0.w, b1.x, b1.y, b1.z, b1.w};
#pragma unroll
            for (int k = 0; k < 4; ++k) { const float g0 = __builtin_bit_cast(float, gg[k] << 16), g1 = __builtin_bit_cast(float, gg[k] & 0xffff0000u);
                const float h0 = (__builtin_bit_cast(float, ff[2 * k] << 16) + __builtin_bit_cast(float, ff[2 * k] & 0xffff0000u) * cf[2 * k]) + (__builtin_bit_cast(float, bb[2 * k] << 16) + __builtin_bit_cast(float, bb[2 * k] & 0xffff0000u) * cbk[2 * k]);
                const float h1 = (__builtin_bit_cast(float, ff[2 * k + 1] << 16) + __builtin_bit_cast(float, ff[2 * k + 1] & 0xffff0000u) * cf[2 * k + 1]) + (__builtin_bit_cast(float, bb[2 * k + 1] << 16) + __builtin_bit_cast(float, bb[2 * k + 1] & 0xffff0000u) * cbk[2 * k + 1]);
                ya[2 * k] = gelu_fast(g0) * h0; ya[2 * k + 1] = gelu_fast(g1) * h1; sa2 += ya[2 * k] * ya[2 * k] + ya[2 * k + 1] * ya[2 * k + 1]; }
            const float ra = rsqrtf(wave_sum(sa2) * (1.0f / DA) + LN_EPS);
            const f32x4 g0 = *(const f32x4*)(gm + lane * 8), g1 = *(const f32x4*)(gm + lane * 8 + 4);
            u32x4 o; o.x = pk2(ya[0] * ra * g0[0], ya[1] * ra * g0[1]); o.y = pk2(ya[2] * ra * g0[2], ya[3] * ra * g0[3]); o.z = pk2(ya[4] * ra * g1[0], ya[5] * ra * g1[1]); o.w = pk2(ya[6] * ra * g1[2], ya[7] * ra * g1[3]);
            *(u32x4*)(Y + (size_t)r * D + lane * 8) = o; } }
        }
        }
        __syncthreads();
    }
}

constexpr int PH_PER_LAYER = 9, N_PHASES = 2 + PH_PER_LAYER * DEPTH;

#define XB_TMO      128
#define XB_XCNT(j)  (256  + 64 * (j))
#define XB_XSUB(j)  (1280 + 64 * (j))
#define XB_XGEN(j)  (2304 + 64 * (j))
#define XB_TOP      3328
#define XB_TOPGEN   3392
#define XCD_BAR_WORDS 3456
#define XB_SPIN_CAP (1u << 18)
__device__ __forceinline__ unsigned xb_ld(unsigned* p)              { return __hip_atomic_load(p, __ATOMIC_RELAXED, __HIP_MEMORY_SCOPE_AGENT); }
__device__ __forceinline__ unsigned xb_add(unsigned* p, unsigned v) { return __hip_atomic_fetch_add(p, v, __ATOMIC_RELAXED, __HIP_MEMORY_SCOPE_AGENT); }
__device__ __forceinline__ unsigned xb_xcc_id() { return (unsigned)__builtin_amdgcn_s_getreg((3 << 11) | 20) & 0xFu; }
#define XB_SPIN(cond, bar) do { unsigned _sp = 0; while (cond) { __builtin_amdgcn_s_sleep(1); \
    if ((++_sp & 255u) == 0u) { if (xb_ld(&(bar)[XB_TMO])) break; if (_sp > XB_SPIN_CAP) { atomicAdd(&(bar)[XB_TMO], 1u); break; } } } } while (0)
__device__ __forceinline__ void xcd_barrier_complete(unsigned* bar, unsigned x, unsigned& nloc, unsigned& nx) {
    const unsigned G = gridDim.x;
    unsigned sum, cnt, mine, sp = 0u;
    for (;;) {
        sum = 0u; cnt = 0u; mine = 0u;
#pragma unroll
        for (unsigned j = 0; j < 16; ++j) { const unsigned c = xb_ld(&bar[XB_XCNT(j)]); sum += c; cnt += (c > 0u) ? 1u : 0u; mine = (j == x) ? c : mine; }
        if (sum == G) break;
        __builtin_amdgcn_s_sleep(1);
        if ((++sp & 255u) == 0u) { if (xb_ld(&bar[XB_TMO])) break; if (sp > XB_SPIN_CAP) { atomicAdd(&bar[XB_TMO], 1u); break; } }
    }
    nloc = mine > 0u ? mine : 1u; nx = cnt > 0u ? cnt : 1u;
}
__device__ __forceinline__ void xcd_barrier(unsigned* bar, unsigned x, volatile PG8_LAS unsigned* st, bool t0) {
    asm volatile("s_waitcnt vmcnt(0)" ::: "memory");
    __syncthreads();
    if (t0) {
        __builtin_amdgcn_s_waitcnt(0);
        unsigned nloc = st[0], nx = st[1];
        if (nloc == 0u) { xcd_barrier_complete(bar, x, nloc, nx); st[0] = nloc; st[1] = nx; }
        const unsigned old = xb_add(&bar[XB_XSUB(x)], 1u);
        const unsigned gen = old / nloc;
        if (old + 1u == (gen + 1u) * nloc) {
            __builtin_amdgcn_fence(__ATOMIC_RELEASE, "agent");
            asm volatile("s_waitcnt vmcnt(0)" ::: "memory");
            const unsigned og = xb_add(&bar[XB_TOP], 1u);
            const unsigned tg = og / nx;
            if (og + 1u == (tg + 1u) * nx) xb_add(&bar[XB_TOPGEN], 1u);
            else XB_SPIN(xb_ld(&bar[XB_TOPGEN]) == tg, bar);
            __builtin_amdgcn_fence(__ATOMIC_ACQUIRE, "agent");
            xb_add(&bar[XB_XGEN(x)], 1u);
            asm volatile("s_waitcnt vmcnt(0)" ::: "memory");
        } else {
            XB_SPIN(xb_ld(&bar[XB_XGEN(x)]) == gen, bar);
            __builtin_amdgcn_fence(__ATOMIC_ACQUIRE, "agent");
            asm volatile("s_waitcnt vmcnt(0)" ::: "memory");
        }
    }
    __syncthreads();
}

__global__ void __launch_bounds__(NTHR, 2) mega(Params p) {
    extern __shared__ __attribute__((aligned(16))) unsigned char lds[];
    cg::grid_group grid = cg::this_grid();
    const int lo = p.ph_lo, hi = p.ph_hi, G = gridDim.x, bid = blockIdx.x;
    const int wv = __builtin_amdgcn_readfirstlane((int)(threadIdx.x >> 6));
    PG8_LAS unsigned char* gl = (PG8_LAS unsigned char*)lds;
#define IN(k) (lo <= (k) && (k) < hi)
    volatile PG8_LAS unsigned* xst = (volatile PG8_LAS unsigned*)(gl + LDS_BYTES - 16);
#define T0() ((wv == 0) && (opaque_lane() == 0))
    const unsigned xcc = xb_xcc_id();
    if (T0()) { xst[0] = 0u; xst[1] = 0u; (void)xb_add((unsigned*)(p.ws + WS_BAR) + XB_XCNT(xcc), 1u); }
    __syncthreads();
    if (hi < 0) grid.sync();
#define GBAR() xcd_barrier((unsigned*)(p.ws + WS_BAR), xcc, xst, T0())
#define SEAM(k) do { if ((k) + 1 < hi) GBAR(); } while (0)
#define PHASE(kind, idx, ...) do { if (IN(idx)) { const int nrep_ = ((kind) == p.dup_k) ? p.dup_n : 1; for (int rep_ = 0; rep_ < nrep_; ++rep_) { if (rep_) GBAR(); Params q = p; asm volatile("" : "+s"(q.ws), "+s"(q.out));   __VA_ARGS__ } SEAM(idx); } } while (0)
    PHASE(9, 0, phase_prologue(q, lds, wv););
    PHASE(10, 1, phase_lnmod0(q, wv););
#pragma unroll 1
    for (int l = 0; l < DEPTH; ++l) {
        const int pb = 2 + PH_PER_LAYER * l; const bool last = (l == DEPTH - 1);
        const int mrows = last ? NLAT : NTOK;
        PHASE(0, pb + 0,
            pg8::Gemm g{(const bf16_t*)(q.ws + WS_XN), (const bf16_t*)(q.ws + WS_WIN) + (size_t)l * DIN * D, NTOK, DIN, D, 0}; pg8::StaticOrder S; S.init(NTOK, DIN, G, bid);
            pg8::EpiBf16<0> E{(bf16_t*)(q.ws + WS_P), DIN, nullptr, 0, 0, 1.0f};
            pg8::gemm_phase<pg8::EpiBf16<0>, pg8::StaticOrder, true, true>(gl, g, S, E, wv););
        PHASE(1, pb + 1, phase_mix1(q, l, lds, wv, rep_ + 1 < nrep_ ? MIX1_REP_MODE : 3););
        PHASE(2, pb + 2,
            phase_carry(q, wv);
            const int nitem = last ? 256 : 264;
            pg8::Gemm g{(const bf16_t*)(q.ws + WS_T), (const bf16_t*)(q.ws + WS_GT), 256, nitem * 256, 256, 0}; pg8::StaticOrder S; S.init(256, nitem * 256, G, bid);
            EpiDftB E{(bf16_t*)(q.ws + WS_V)};
            pg8::gemm_phase<EpiDftB, pg8::StaticOrder, true, true>(gl, g, S, E, wv););
        PHASE(3, pb + 3, phase_mix3(q, l, lds, wv, rep_ + 1 < nrep_ ? MIX3_REP_MODE : 15););
        PHASE(4, pb + 4,
            pg8::Gemm g{(const bf16_t*)(q.ws + WS_Y), (const bf16_t*)(q.ws + WS_WOUT) + (size_t)l * D * D, mrows, D, D, 0}; pg8::StaticOrder S; S.init(mrows, D, G, bid);
            pg8::EpiBf16<0> E{(bf16_t*)(q.ws + WS_XN), D, nullptr, 0, 0, 1.0f};
            pg8::gemm_phase<pg8::EpiBf16<0>, pg8::StaticOrder, true, true>(gl, g, S, E, wv););
        PHASE(5, pb + 5, const float* sml = (const float*)(q.ws + WS_SM) + (size_t)l * SM_PER_LAYER; phase_ln(q, mrows, sml + SM_LN1G, sml + SM_LN1B, l, 2, l, 3, 4, wv, rep_ + 1 < nrep_ ? 1 : 0););
        PHASE(6, pb + 6,
            pg8::Gemm g{(const bf16_t*)(q.ws + WS_XN), (const bf16_t*)(q.ws + WS_WUP) + (size_t)l * 2 * DFF * D, mrows, 2 * DFF, D, 0}; pg8::StaticOrder S; S.init(mrows, 2 * DFF, G, bid);
            EpiSwiglu E{(bf16_t*)(q.ws + WS_H)};
            pg8::gemm_phase<EpiSwiglu, pg8::StaticOrder, true, true>(gl, g, S, E, wv););
        PHASE(7, pb + 7,
            pg8::Gemm g{(const bf16_t*)(q.ws + WS_H), (const bf16_t*)(q.ws + WS_WDN) + (size_t)l * D * DFF, mrows, D, DFF, 0}; pg8::StaticOrder S; S.init(mrows, D, G, bid);
            pg8::EpiBf16<0> E{(bf16_t*)(q.ws + WS_XN), D, nullptr, 0, 0, 1.0f};
            pg8::gemm_phase<pg8::EpiBf16<0>, pg8::StaticOrder, true, true>(gl, g, S, E, wv););
        PHASE(8, pb + 8, const float* sml = (const float*)(q.ws + WS_SM) + (size_t)l * SM_PER_LAYER; phase_ln(q, mrows, sml + SM_LN2G, sml + SM_LN2B, l, 5, last ? -1 : l + 1, 0, 1, wv, rep_ + 1 < nrep_ ? 1 : 0););
    }
#undef PHASE
#ifdef EXTRA_SYNCS
    for (int i = 0; i < EXTRA_SYNCS; ++i) GBAR();
#endif
#undef IN
#undef SEAM
#undef GBAR
#undef T0
}

}

extern "C" void kernel_launch(void* const* d_in, const int* in_sizes, int n_in, void* d_out, int out_size, void* d_ws, size_t ws_size, hipStream_t stream) {
    unsigned char* ws = (unsigned char*)d_ws;
    static int grid = 0;
    if (grid == 0) {
        if (n_in != 25 || in_sizes[0] != NLAT * D || out_size != NLAT * D || ws_size < WS_END) {
            fprintf(stderr, "kernel_launch: built for 25 inputs, x/out of %d floats and >= %zu bytes of workspace; got n_in %d, in0 %d, out %d, ws %zu; nothing launched\n", NLAT * D, (size_t)WS_END, n_in, n_in > 0 ? in_sizes[0] : -1, out_size, ws_size);
            grid = -1; return; }
        int dev = 0, cus = 0, per_cu = 0;
        if (hipGetDevice(&dev) != hipSuccess || hipDeviceGetAttribute(&cus, hipDeviceAttributeMultiprocessorCount, dev) != hipSuccess) { fprintf(stderr, "kernel_launch: device query failed\n"); grid = -1; return; }
        if (hipFuncSetAttribute((const void*)mega, hipFuncAttributeMaxDynamicSharedMemorySize, LDS_BYTES) != hipSuccess) fprintf(stderr, "kernel_launch: hipFuncSetAttribute failed\n");
        if (hipOccupancyMaxActiveBlocksPerMultiprocessor(&per_cu, (const void*)mega, NTHR, LDS_BYTES) != hipSuccess || per_cu < 1) { fprintf(stderr, "kernel_launch: occupancy query reports %d workgroups per CU\n", per_cu); per_cu = 1; }
        (void)hipGetLastError();
        grid = cus;
    }
    if (grid < 0) return;
    Params base{};
    for (int i = 0; i < 25; ++i) base.in[i] = (const float*)d_in[i];
    base.out = (float*)d_out; base.ws = ws;
#ifdef DUP_K
    base.dup_k = DUP_K; base.dup_n = DUP_N;
#else
    base.dup_k = -1; base.dup_n = 1;
#endif
    base.ph_lo = 0; base.ph_hi = N_PHASES;
    if (hipMemsetAsync(ws + WS_BAR, 0, (size_t)XCD_BAR_WORDS * 4, stream) != hipSuccess) fprintf(stderr, "kernel_launch: memset of the barrier words failed\n");
    void* args[] = {&base};
    const hipError_t e = hipLaunchCooperativeKernel((const void*)mega, dim3(grid), dim3(NTHR), args, LDS_BYTES, stream);
    if (e != hipSuccess) fprintf(stderr, "kernel_launch: cooperative launch failed: %s (grid %d)\n", hipGetErrorString(e), grid);
}
```

```cpp
#include <hip/hip_runtime.h>
#include <hip/hip_cooperative_groups.h>
#ifndef MIX3_REP_MODE
#define MIX3_REP_MODE 15
#endif
#ifndef MIX1_REP_MODE
#define MIX1_REP_MODE 3
#endif
#include <cstdint>
#include <cstdio>
#include <cmath>

namespace cg = cooperative_groups;
namespace pg8 {
#define PG8_LAS __attribute__((address_space(3)))
typedef unsigned short bf16_t;
typedef short bf16x8 __attribute__((ext_vector_type(8)));
typedef float f32x4 __attribute__((ext_vector_type(4)));
typedef unsigned u32x4 __attribute__((ext_vector_type(4)));
constexpr int BM = 256, BK = 64, HALF = 128, HTB = HALF * BK * 2  , STAGE_BYTES = 8 * HTB, NXCD = 8, WGM = 8;

__host__ __device__ __forceinline__ int lds_byte(int r, int c) { const int st = (r >> 4) * 2 + (c >> 5), rr = r & 15, cc = c & 31, ob = rr * 64 + cc * 2; return st * 1024 + (ob ^ (((ob >> 9) & 1) << 5)); }
__host__ __device__ __forceinline__ void stage_rc(int b, int& R, int& C) { const int st = b / 1024, sb = b % 1024, swz = sb ^ (((sb >> 9) & 1) << 5); R = (st >> 1) * 16 + swz / 64; C = (st & 1) * 32 + (swz % 64) / 2; }
__host__ __device__ __forceinline__ int perm32(int rho) { const int n = rho >> 4, i = rho & 15; return 8 * (i >> 2) + 4 * n + (i & 3); }

struct Unit { int pm, pn; };
struct Gemm { const bf16_t* A; const bf16_t* Bt; int M, N, K, pad; };

struct StaticOrder {
    int nM, nN, nwg, G, c;
    __host__ __device__ void init(int M, int N, int G_, int c_) { nM = M / BM; nN = N / BM; nwg = nM * nN; G = G_; c = c_; }
    __host__ __device__ bool next(int i, Unit& u) const {
        const long L = (long)i * G + c; if (L >= nwg) return false;
        int wgid = (int)L; { const int q = nwg / NXCD, r = nwg % NXCD, xcd = wgid % NXCD, off = wgid / NXCD; wgid = (xcd < r ? xcd * (q + 1) : r * (q + 1) + (xcd - r) * q) + off; }
        const int nig = WGM * nN, gid = wgid / nig, fm = gid * WGM, gsz = (nM - fm) < WGM ? (nM - fm) : WGM;
        u.pm = fm + ((wgid % nig) % gsz); u.pn = (wgid % nig) / gsz; return true;
    }
    __device__ __forceinline__ void a_ready(const Unit&) const {}
    __device__ __forceinline__ void done(const Unit&) const {}
};

__device__ __forceinline__ unsigned cvt_pk_bf16(float lo, float hi) { unsigned r; asm volatile("v_cvt_pk_bf16_f32 %0, %1, %2" : "=v"(r) : "v"(lo), "v"(hi)); return r; }
typedef float f32x2 __attribute__((ext_vector_type(2)));
__device__ __forceinline__ f32x2 gelu_pk(f32x2 v) {
    const f32x2 av = __builtin_elementwise_abs(v), d = av * 0.2316418882f + 1.0f;
    f32x2 t; t.x = __builtin_amdgcn_rcpf(d.x); t.y = __builtin_amdgcn_rcpf(d.y);
    f32x2 q = t * 0.5307027145f + (-0.7265760135f); q = q * t + 0.7107068705f; q = q * t + (-0.142248368f); q = q * t + 0.127414796f; q = q * t;
    const f32x2 s = (v * v) * (-0.72134752044f);
    f32x2 e; e.x = __builtin_amdgcn_exp2f(s.x); e.y = __builtin_amdgcn_exp2f(s.y);
    const f32x2 m = v * (q * e), r = v - m;
    f32x2 o; o.x = v.x < 0.f ? m.x : r.x; o.y = v.y < 0.f ? m.y : r.y; return o;
}

template <int ACT  > struct EpiBf16 {
    static constexpr bool PERM = true, AFTER_DRAIN = false; static_assert(ACT == 0 || ACT == 1, "EpiBf16: ACT is 0 (none) or 1 (gelu_pk)");
    bf16_t* O; int ldc; const float* bias; int split_cols; size_t split_stride; float scale0;
    __device__ __forceinline__ void operator()(const f32x4 (&acc)[2][2][4][2], const Unit& u, int wr, int wc, int fr, int fq) const {
        const int row0 = u.pm * BM + wr * 64 + fr; int colt = u.pn * BM; bf16_t* base = O;
        float sc = 1.f; if (split_cols) { const int t = colt / split_cols; base += (size_t)t * split_stride; colt -= t * split_cols; if (t == 0) sc = scale0; }
        const int col0 = colt + wc * 32 + 8 * fq, bcol0 = u.pn * BM + wc * 32 + 8 * fq;
        f32x4 bv[2][2];
#pragma unroll
        for (int bj = 0; bj < 2; ++bj)
#pragma unroll
            for (int n = 0; n < 2; ++n) bv[bj][n] = bias ? *(const f32x4*)(bias + bcol0 + bj * HALF + 4 * n) : (f32x4){0.f, 0.f, 0.f, 0.f};
#pragma unroll
        for (int ai = 0; ai < 2; ++ai)
#pragma unroll
            for (int m = 0; m < 4; ++m) { bf16_t* rowp = base + (size_t)(row0 + ai * HALF + m * 16) * ldc + col0;
#pragma unroll
                for (int bj = 0; bj < 2; ++bj) { f32x4 v0 = acc[ai][bj][m][0] + bv[bj][0], v1 = acc[ai][bj][m][1] + bv[bj][1];
                    if (ACT == 1) { f32x2 a = gelu_pk((f32x2){v0[0], v0[1]}), b = gelu_pk((f32x2){v0[2], v0[3]}), c = gelu_pk((f32x2){v1[0], v1[1]}), d = gelu_pk((f32x2){v1[2], v1[3]});
                        v0 = (f32x4){a.x, a.y, b.x, b.y}; v1 = (f32x4){c.x, c.y, d.x, d.y}; }
                    v0 = v0 * sc; v1 = v1 * sc; u32x4 w; w.x = cvt_pk_bf16(v0[0], v0[1]); w.y = cvt_pk_bf16(v0[2], v0[3]); w.z = cvt_pk_bf16(v1[0], v1[1]); w.w = cvt_pk_bf16(v1[2], v1[3]);
                    *(u32x4*)(rowp + bj * HALF) = w; } }
    }
};

struct EpiF32 {
    static constexpr bool PERM = false, AFTER_DRAIN = false;
    float* C; const float* bias; int ldc, pad;
    __device__ __forceinline__ void operator()(const f32x4 (&acc)[2][2][4][2], const Unit& u, int wr, int wc, int fr, int fq) const {
        const int row0 = u.pm * BM + wr * 64 + fr, col0 = u.pn * BM + wc * 32 + 4 * fq;
        f32x4 bv[2][2];
#pragma unroll
        for (int bj = 0; bj < 2; ++bj)
#pragma unroll
            for (int n = 0; n < 2; ++n) bv[bj][n] = bias ? *(const f32x4*)(bias + col0 + bj * HALF + n * 16) : (f32x4){0.f, 0.f, 0.f, 0.f};
#pragma unroll
        for (int ai = 0; ai < 2; ++ai)
#pragma unroll
            for (int m = 0; m < 4; ++m) { float* rowp = C + (size_t)(row0 + ai * HALF + m * 16) * ldc + col0;
#pragma unroll
                for (int bj = 0; bj < 2; ++bj)
#pragma unroll
                    for (int n = 0; n < 2; ++n) *(f32x4*)(rowp + bj * HALF + n * 16) = acc[ai][bj][m][n] + bv[bj][n]; }
    }
};

template <class Epi, class Sched, bool ALIGN_EPI = false, bool SP2 = false>
__device__ __forceinline__ void gemm_phase(PG8_LAS unsigned char* lds, const Gemm g, const Sched& S, const Epi& E, int wv_) {
    int ln_; asm volatile("v_mbcnt_lo_u32_b32 %0, -1, 0\n\tv_mbcnt_hi_u32_b32 %0, -1, %0" : "=v"(ln_)); const int tid_ = (wv_ << 6) | ln_;
    const int tid = tid_, wid = __builtin_amdgcn_readfirstlane(tid >> 6), lane = tid & 63, wr = wid >> 2, wc = wid & 3, fr = lane & 15, fq = lane >> 4;
    const int K = g.K, nt = K / BK;
    unsigned voffA[2], voffB[2];
#pragma unroll
    for (int i = 0; i < 2; ++i) { int R, C; stage_rc(tid * 16 + i * 8192, R, C); const int Rb = Epi::PERM ? ((R & ~31) + perm32(R & 31)) : R;
        voffA[i] = (unsigned)(R * K + C) * 2u; voffB[i] = (unsigned)(Rb * K + C) * 2u; }
    const size_t kstep = (size_t)(BK * 2);
    const size_t hstep = (size_t)HALF * K * 2;
    const size_t tstep = 2 * hstep;
    const unsigned ldsw = (unsigned)wid * 1024u;
    const int aoff = lds_byte(wr * 64 + fr, fq * 8), boff = lds_byte(wc * 32 + fr, fq * 8);
#define PG8_SA(b, h) (((b) * 2 + (h)) * HTB)
#define PG8_SB(b, h) ((4 + (b) * 2 + (h)) * HTB)
#define PG8_STAGE(bufoff, gbase, voff) do { _Pragma("unroll") for (int _i = 0; _i < 2; ++_i) \
        __builtin_amdgcn_global_load_lds((const unsigned*)((const char*)(gbase) + (voff)[_i]), (PG8_LAS unsigned*)(lds + (bufoff) + ldsw + _i * 8192), 16, 0, 0); } while (0)
#define PG8_LDA(dst, b, h) do { _Pragma("unroll") for (int m = 0; m < 4; ++m) _Pragma("unroll") for (int k = 0; k < 2; ++k) dst[m][k] = *(const PG8_LAS bf16x8*)(lds + PG8_SA(b, h) + aoff + m * 2048 + k * 1024); } while (0)
#define PG8_LDB(dst, b, h) do { _Pragma("unroll") for (int n = 0; n < 2; ++n) _Pragma("unroll") for (int k = 0; k < 2; ++k) dst[n][k] = *(const PG8_LAS bf16x8*)(lds + PG8_SB(b, h) + boff + n * 2048 + k * 1024); } while (0)
#define PG8_MMA(ai, bj, At, Bt) do { __builtin_amdgcn_s_setprio(1); _Pragma("unroll") for (int m = 0; m < 4; ++m) _Pragma("unroll") for (int n = 0; n < 2; ++n) _Pragma("unroll") for (int k = 0; k < 2; ++k) \
        acc[ai][bj][m][n] = __builtin_amdgcn_mfma_f32_16x16x32_bf16(Bt[n][k], At[m][k], acc[ai][bj][m][n], 0, 0, 0); __builtin_amdgcn_s_setprio(0); } while (0)
#define PG8_WAIT_V(n) asm volatile("s_waitcnt vmcnt(" #n ")" ::: "memory")
#define PG8_WAIT_L(n) asm volatile("s_waitcnt lgkmcnt(" #n ")" ::: "memory")
#define PG8_BAR __builtin_amdgcn_s_barrier()
#define PG8_SCHED __builtin_amdgcn_sched_barrier(0)
    Unit cur, nxt; int ui = 0;
    if (!S.next(0, cur)) return;
    f32x4 acc[2][2][4][2];
#pragma unroll
    for (int a = 0; a < 2; ++a)
#pragma unroll
        for (int b = 0; b < 2; ++b)
#pragma unroll
            for (int m = 0; m < 4; ++m)
#pragma unroll
                for (int n = 0; n < 2; ++n) acc[a][b][m][n] = (f32x4){0.f, 0.f, 0.f, 0.f};
    bf16x8 At[4][2], B0[2][2], B1[2][2];
    const char* cA = (const char*)g.A + (size_t)cur.pm * tstep; const char* cB = (const char*)g.Bt + (size_t)cur.pn * tstep;
    S.a_ready(cur);
    if constexpr (SP2) {
        PG8_STAGE(PG8_SB(0, 0), cB, voffB); PG8_STAGE(PG8_SB(0, 1), cB + hstep, voffB); PG8_STAGE(PG8_SA(0, 0), cA, voffA); PG8_STAGE(PG8_SA(0, 1), cA + hstep, voffA);
        if (wr == 1) PG8_BAR;
        PG8_WAIT_V(2); PG8_BAR;
        PG8_STAGE(PG8_SB(1, 0), cB + kstep, voffB); PG8_STAGE(PG8_SA(1, 0), cA + kstep, voffA); PG8_STAGE(PG8_SB(1, 1), cB + hstep + kstep, voffB);
        PG8_WAIT_V(6); PG8_BAR;
    } else {
        PG8_STAGE(PG8_SB(0, 0), cB, voffB); PG8_STAGE(PG8_SA(0, 0), cA, voffA); PG8_STAGE(PG8_SB(0, 1), cB + hstep, voffB); PG8_STAGE(PG8_SA(0, 1), cA + hstep, voffA);
        if (wr == 1) PG8_BAR;
        PG8_WAIT_V(4); PG8_BAR;
        PG8_STAGE(PG8_SB(1, 0), cB + kstep, voffB); PG8_STAGE(PG8_SA(1, 0), cA + kstep, voffA); PG8_STAGE(PG8_SB(1, 1), cB + hstep + kstep, voffB);
        PG8_WAIT_V(6); PG8_BAR;
    }
    for (;;) {
        const bool has_next = S.next(ui + 1, nxt);
        const char* nA = has_next ? (const char*)g.A + (size_t)nxt.pm * tstep : cA; const char* nB = has_next ? (const char*)g.Bt + (size_t)nxt.pn * tstep : cB;
        for (int t = 0; t < nt; t += 2) {
            const bool last = (t == nt - 2);
            const char* a1 = cA + (size_t)(t + 1) * kstep;
            const char* a2 = last ? nA : cA + (size_t)(t + 2) * kstep; const char* b2 = last ? nB : cB + (size_t)(t + 2) * kstep;
            const char* a3 = a2 + kstep; const char* b3 = b2 + kstep;
            if (last && has_next) S.a_ready(nxt);
            if constexpr (SP2) {
            PG8_LDB(B0, 0, 0); PG8_LDB(B1, 0, 1); PG8_SCHED; PG8_LDA(At, 0, 0); PG8_STAGE(PG8_SA(1, 1), a1 + hstep, voffA);
            PG8_WAIT_V(8); PG8_WAIT_L(0); PG8_BAR; PG8_MMA(0, 0, At, B0); PG8_MMA(0, 1, At, B1); PG8_BAR; PG8_SCHED;
            PG8_LDA(At, 0, 1); PG8_STAGE(PG8_SB(0, 0), b2, voffB); PG8_STAGE(PG8_SB(0, 1), b2 + hstep, voffB); PG8_STAGE(PG8_SA(0, 0), a2, voffA);
            PG8_WAIT_V(8); PG8_WAIT_L(0); PG8_BAR; PG8_MMA(1, 0, At, B0); PG8_MMA(1, 1, At, B1); PG8_BAR; PG8_SCHED;
            PG8_LDB(B0, 1, 0); PG8_LDB(B1, 1, 1); PG8_SCHED; PG8_LDA(At, 1, 0); PG8_STAGE(PG8_SA(0, 1), a2 + hstep, voffA);
            PG8_WAIT_V(8); PG8_WAIT_L(0); PG8_BAR; PG8_MMA(0, 0, At, B0); PG8_MMA(0, 1, At, B1); PG8_BAR; PG8_SCHED;
            PG8_LDA(At, 1, 1); PG8_STAGE(PG8_SB(1, 0), b3, voffB); PG8_STAGE(PG8_SB(1, 1), b3 + hstep, voffB); PG8_STAGE(PG8_SA(1, 0), a3, voffA);
            PG8_WAIT_V(8); PG8_WAIT_L(0); PG8_BAR; PG8_MMA(1, 0, At, B0); PG8_MMA(1, 1, At, B1); PG8_BAR; PG8_SCHED;
            } else {
            PG8_LDB(B0, 0, 0); PG8_SCHED; PG8_LDA(At, 0, 0); PG8_STAGE(PG8_SA(1, 1), a1 + hstep, voffA);
            PG8_WAIT_L(8); PG8_BAR; PG8_WAIT_L(0); PG8_MMA(0, 0, At, B0); PG8_BAR; PG8_SCHED;
            PG8_LDB(B1, 0, 1); PG8_STAGE(PG8_SB(0, 0), b2, voffB);
            PG8_BAR; PG8_WAIT_L(0); PG8_MMA(0, 1, At, B1); PG8_BAR;
            PG8_LDA(At, 0, 1); PG8_STAGE(PG8_SA(0, 0), a2, voffA);
            PG8_BAR; PG8_WAIT_L(0); PG8_MMA(1, 0, At, B0); PG8_BAR; PG8_SCHED;
            PG8_STAGE(PG8_SB(0, 1), b2 + hstep, voffB);
            PG8_WAIT_V(6); PG8_BAR; PG8_MMA(1, 1, At, B1); PG8_BAR;
            PG8_LDB(B0, 1, 0); PG8_SCHED; PG8_LDA(At, 1, 0); PG8_STAGE(PG8_SA(0, 1), a2 + hstep, voffA);
            PG8_WAIT_L(8); PG8_BAR; PG8_WAIT_L(0); PG8_MMA(0, 0, At, B0); PG8_BAR; PG8_SCHED;
            PG8_LDB(B1, 1, 1); PG8_STAGE(PG8_SB(1, 0), b3, voffB);
            PG8_BAR; PG8_WAIT_L(0); PG8_MMA(0, 1, At, B1); PG8_BAR;
            PG8_LDA(At, 1, 1); PG8_STAGE(PG8_SA(1, 0), a3, voffA);
            PG8_BAR; PG8_WAIT_L(0); PG8_MMA(1, 0, At, B0); PG8_BAR; PG8_SCHED;
            PG8_STAGE(PG8_SB(1, 1), b3 + hstep, voffB);
            PG8_WAIT_V(6); PG8_BAR; PG8_MMA(1, 1, At, B1); PG8_BAR;
            }
        }
        if constexpr (ALIGN_EPI) { if (wr == 0) PG8_BAR; }
        if constexpr (!Epi::AFTER_DRAIN) { E(acc, cur, wr, wc, fr, fq); S.done(cur); }
        if (!has_next) break;
#pragma unroll
        for (int a = 0; a < 2; ++a)
#pragma unroll
            for (int b = 0; b < 2; ++b)
#pragma unroll
                for (int m = 0; m < 4; ++m)
#pragma unroll
                    for (int n = 0; n < 2; ++n) acc[a][b][m][n] = (f32x4){0.f, 0.f, 0.f, 0.f};
        cur = nxt; cA = nA; cB = nB; ++ui;
        if constexpr (ALIGN_EPI) { if (wr == 1) PG8_BAR; }
    }
    PG8_WAIT_V(0);
    if constexpr (!ALIGN_EPI) { if (wr == 0) PG8_BAR; }
    PG8_BAR;
    if constexpr (Epi::AFTER_DRAIN) { E.fused(acc, cur, wr, wc, fr, fq, lds, wid, lane); S.done(cur); }
#undef PG8_SA
#undef PG8_SB
#undef PG8_STAGE
#undef PG8_LDA
#undef PG8_LDB
#undef PG8_MMA
#undef PG8_WAIT_V
#undef PG8_WAIT_L
#undef PG8_BAR
#undef PG8_SCHED
}
}

namespace {
constexpr int D = 1024, NB = 4, SEQ = 8192, CTX = 256, DEPTH = 2;
constexpr int DA = 512, DB = 256, DC = 256, DIN = 1792, HD = 64, CHUNK = 128, DFF = 2816, NMOD = 6;
constexpr int NLAT = NB * SEQ, NCTX = NB * CTX;
constexpr float LN_EPS = 1e-6f;
constexpr float ALPHA = 1.41421356237309515f;
constexpr float PI_F = 3.14159265358979323846f;

typedef unsigned short bf16_t;
__device__ __forceinline__ bf16_t f2bf(float f) { unsigned r; asm("v_cvt_pk_bf16_f32 %0, %1, %1" : "=v"(r) : "v"(f)); return (bf16_t)(r & 0xffffu); }
__device__ __forceinline__ float bf2f(bf16_t h) { return __builtin_bit_cast(float, (unsigned)h << 16); }
__device__ __forceinline__ void st_val(float* p, float v) { *p = v; }
__device__ __forceinline__ void st_val(bf16_t* p, float v) { *p = f2bf(v); }
__device__ __forceinline__ float gelu_f(float v) { return 0.5f * v * (1.0f + erff(v * 0.70710678118654752f)); }
__device__ __forceinline__ float sigmoid_f(float v) { return 1.0f / (1.0f + expf(-v)); }
__device__ __forceinline__ float silu_f(float v) { return v / (1.0f + expf(-v)); }

__device__ __forceinline__ float block_sum256(float v, float* sh) {
#pragma unroll
    for (int o = 32; o > 0; o >>= 1) v += __shfl_xor(v, o);
    __syncthreads();
    if ((threadIdx.x & 63) == 0) sh[threadIdx.x >> 6] = v;
    __syncthreads();
    return (sh[0] + sh[1]) + (sh[2] + sh[3]);
}

constexpr int NTOK = NLAT + NCTX, NCHUNK = NTOK / CHUNK;
constexpr size_t al256(size_t x) { return (x + 255) & ~(size_t)255; }
constexpr size_t WS_MOD = 0;
constexpr size_t WS_TAB = WS_MOD + al256((size_t)DEPTH * 5 * NMOD * D * 4);
constexpr size_t WS_XCTX = WS_TAB + al256((size_t)2 * 8192 * 4);
constexpr size_t WS_HC = WS_XCTX + al256((size_t)NCTX * D * 4);
constexpr size_t WS_AGG = WS_HC + al256((size_t)NB * 2 * DA * 4);
constexpr size_t WS_T = WS_AGG + al256((size_t)NCHUNK * 2 * 2 * DA * 4);
constexpr size_t WS_MM = WS_T + al256((size_t)256 * 256 * 2);
constexpr int SM_CONVW = 0, SM_CONVB = 2048, SM_BA = 2560, SM_BX = 3584, SM_SP8 = 4608, SM_SGB = 5632, SM_GMIX = 6144, SM_LN1G = 7168, SM_LN1B = 8192, SM_LN2G = 9216, SM_LN2B = 10240, SM_PER_LAYER = 11264;
constexpr size_t WS_SM = WS_MM + al256((size_t)DEPTH * 4 * 128 * 64 * 4);
constexpr size_t WS_SGW = WS_SM + al256((size_t)DEPTH * SM_PER_LAYER * 4);
constexpr size_t WS_SGWB = WS_SGW + al256((size_t)DEPTH * 4 * CHUNK * CHUNK * 4);
constexpr size_t WS_MMT = WS_SGWB + al256((size_t)DEPTH * 4 * CHUNK * CHUNK * 2);
constexpr size_t WS_WG = WS_MMT + al256((size_t)DEPTH * 4 * 64 * 128 * 2);
constexpr size_t WS_WIN = WS_WG + al256((size_t)2 * DEPTH * 2 * 8 * 64 * 64 * 2);
constexpr size_t WS_WOUT = WS_WIN + al256((size_t)DEPTH * DIN * D * 2);
constexpr size_t WS_WUP = WS_WOUT + al256((size_t)DEPTH * D * D * 2);
constexpr size_t WS_WDN = WS_WUP + al256((size_t)DEPTH * 2 * DFF * D * 2);
constexpr size_t WS_XN = WS_WDN + al256((size_t)DEPTH * D * DFF * 2);
constexpr size_t WS_GT = WS_XN;
constexpr size_t WS_V = WS_XN + (size_t)NTOK * 512 * 2;
constexpr size_t WS_P = WS_XN + al256((size_t)NTOK * D * 2);
constexpr size_t WS_Y = WS_P + (size_t)NTOK * DIN * 2;
constexpr size_t WS_H = WS_P;
constexpr size_t WS_HF = WS_Y + al256((size_t)NTOK * D * 2);
constexpr size_t WS_HB = WS_HF + al256((size_t)NTOK * DA * 2);
constexpr size_t WS_AF = WS_HB + al256((size_t)NTOK * DA * 2);
constexpr size_t WS_AB = WS_AF + al256((size_t)NTOK * DA * 2);
constexpr size_t WS_TA = WS_AB + al256((size_t)NTOK * DA * 2);
constexpr size_t WS_CARRY = WS_TA + al256((size_t)128 * 64 * 2);
constexpr size_t WS_BAR = WS_CARRY + al256((size_t)NCHUNK * 2 * DA * 4);
constexpr size_t WS_END = WS_BAR + al256((size_t)3456 * 4);
static_assert((size_t)NTOK * DFF * 2 == (size_t)NTOK * DIN * 2 + (size_t)NTOK * D * 2, "H overlays exactly P + Y");
constexpr int LDS_BYTES = 147456;
constexpr int NTHR = 512, NWAVE = 8;

struct Params { const float* in[25]; float* out; unsigned char* ws; int ph_lo, ph_hi, dup_k, dup_n; int sc_rounds, sc_nextra, sc_esh, pad; };
enum { I_X = 0, I_C, I_CTX, I_CCTX, I_WMOD, I_BMOD, I_WIN, I_CONVW, I_CONVB, I_WA, I_BA, I_WX, I_BX, I_LAM, I_SGW, I_SGB, I_FW, I_GMIX, I_WOUT, I_LN1G, I_LN1B, I_WUP, I_WDN, I_LN2G, I_LN2B };

typedef float f32x4 __attribute__((ext_vector_type(4)));
typedef unsigned u32x2 __attribute__((ext_vector_type(2)));
typedef unsigned u32x4 __attribute__((ext_vector_type(4)));
__device__ __forceinline__ int opaque_lane() { int l; asm volatile("v_mbcnt_lo_u32_b32 %0, -1, 0\n\tv_mbcnt_hi_u32_b32 %0, -1, %0" : "=v"(l)); return l; }
__device__ __forceinline__ int opaque_tid(int wv) { return (wv << 6) | opaque_lane(); }
__device__ __forceinline__ unsigned pk2(float lo, float hi) { unsigned r; asm("v_cvt_pk_bf16_f32 %0, %1, %2" : "=v"(r) : "v"(lo), "v"(hi)); return r; }
__device__ __forceinline__ float wave_sum(float v) {
#pragma unroll
    for (int o = 1; o < 64; o <<= 1) v += __shfl_xor(v, o);
    return v;
}
__device__ __forceinline__ float* xrow_ptr(const Params& p, int r) { return r < NLAT ? p.out + (size_t)r * D : (float*)(p.ws + WS_XCTX) + (size_t)(r - NLAT) * D; }
__device__ __forceinline__ int mod_row(int r) { return r < NLAT ? r / SEQ : 4; }
__device__ __forceinline__ const float* mod_ptr(const Params& p, int l, int r, int idx) { return (const float*)(p.ws + WS_MOD) + ((size_t)(l * 5 + mod_row(r)) * NMOD + idx) * D; }

struct EpiResid {
    static constexpr bool PERM = false, AFTER_DRAIN = false;
    float* xlat; float* xctx; const float* modl; int gate_idx; int dry;
    __device__ __forceinline__ void operator()(const pg8::f32x4 (&acc)[2][2][4][2], const pg8::Unit& u, int wr, int wc, int fr, int fq) const {
        const int rt = u.pm * 256;
        float* xb = rt < NLAT ? xlat + (size_t)rt * D : xctx + (size_t)(rt - NLAT) * D;
        const float* gp = modl + ((size_t)(rt < NLAT ? rt / SEQ : 4) * NMOD + gate_idx) * D;
        const int row0 = wr * 64 + fr, col0 = u.pn * 256 + wc * 32 + 4 * fq;
        pg8::f32x4 gv[2][2];
#pragma unroll
        for (int bj = 0; bj < 2; ++bj)
#pragma unroll
            for (int n = 0; n < 2; ++n) gv[bj][n] = *(const pg8::f32x4*)(gp + col0 + bj * 128 + n * 16);
#pragma unroll
        for (int ai = 0; ai < 2; ++ai)
#pragma unroll
            for (int m = 0; m < 4; ++m) { float* rowp = xb + (size_t)(row0 + ai * 128 + m * 16) * D + col0;
#pragma unroll
                for (int bj = 0; bj < 2; ++bj)
#pragma unroll
                    for (int n = 0; n < 2; ++n) { const pg8::f32x4 xv = *(const pg8::f32x4*)(rowp + bj * 128 + n * 16); const pg8::f32x4 zv = xv * ALPHA + gv[bj][n] * acc[ai][bj][m][n]; *(pg8::f32x4*)(rowp + bj * 128 + n * 16) = dry ? xv : zv; }
                asm volatile("" ::: "memory"); }
    }
};
__device__ __forceinline__ float silu_fast(float v) { return v * __builtin_amdgcn_rcpf(1.0f + __builtin_amdgcn_exp2f(-1.44269504089f * v)); }
struct EpiSwiglu {
    static constexpr bool PERM = true, AFTER_DRAIN = false;
    bf16_t* H;
    __device__ __forceinline__ void operator()(const pg8::f32x4 (&acc)[2][2][4][2], const pg8::Unit& u, int wr, int wc, int fr, int fq) const {
        const int row0 = u.pm * 256 + wr * 64 + fr, col0 = u.pn * 128 + wc * 32 + 8 * fq;
#pragma unroll
        for (int ai = 0; ai < 2; ++ai)
#pragma unroll
            for (int m = 0; m < 4; ++m) { bf16_t* rowp = H + (size_t)(row0 + ai * 128 + m * 16) * DFF + col0;
                const pg8::f32x4 g0 = acc[ai][0][m][0], g1 = acc[ai][0][m][1], u0 = acc[ai][1][m][0], u1 = acc[ai][1][m][1];
                pg8::u32x4 w;
                w.x = pk2(silu_fast(g0[0]) * u0[0], silu_fast(g0[1]) * u0[1]); w.y = pk2(silu_fast(g0[2]) * u0[2], silu_fast(g0[3]) * u0[3]);
                w.z = pk2(silu_fast(g1[0]) * u1[0], silu_fast(g1[1]) * u1[1]); w.w = pk2(silu_fast(g1[2]) * u1[2], silu_fast(g1[3]) * u1[3]);
                *(pg8::u32x4*)rowp = w; }
    }
};

__device__ __forceinline__ void transpose_item(const float* W, int K, int N, bf16_t* WT, int src_n0, int dst_n0, int k0, float* scr, int lane) {
#pragma unroll 16
    for (int i = 0; i < 32; ++i) { const int kk = 2 * i + (lane >> 5); scr[kk * 33 + (lane & 31)] = W[(size_t)(k0 + kk) * N + src_n0 + (lane & 31)]; }
    __builtin_amdgcn_s_waitcnt(0); __builtin_amdgcn_wave_barrier();
    const int c = lane & 7;
#pragma unroll
    for (int j = 0; j < 4; ++j) { const int n = (lane >> 3) + 8 * j; const float* sp = scr + (8 * c) * 33 + n;
        u32x4 o; o.x = pk2(sp[0 * 33], sp[1 * 33]); o.y = pk2(sp[2 * 33], sp[3 * 33]); o.z = pk2(sp[4 * 33], sp[5 * 33]); o.w = pk2(sp[6 * 33], sp[7 * 33]);
        *(u32x4*)(WT + (size_t)(dst_n0 + n) * K + k0 + 8 * c) = o; }
    __builtin_amdgcn_s_waitcnt(0); __builtin_amdgcn_wave_barrier();
}

__device__ __forceinline__ void phase_prologue(const Params& p, unsigned char* lds, int wv) {
    const int tid = opaque_tid(wv), lane = tid & 63, wave = tid >> 6, bid = blockIdx.x, G = gridDim.x;
    const int gtid = bid * NTHR + tid, GT_ = G * NTHR, gw = bid * NWAVE + wave, NGW = G * NWAVE;
    {
        float* sc = (float*)lds; float* red = (float*)(lds + 20480);
        bool have = false;
        for (int it = bid; it < DEPTH * 96; it += G) {
            if (!have) { for (int i = tid; i < 5 * D; i += NTHR) { const int r = i / D, k = i % D; const float v = r < 4 ? p.in[I_C][r * D + k] : p.in[I_CCTX][k]; sc[i] = silu_f(v); } have = true; }
            __syncthreads();
            const int l = it / 96, col = (it % 96) * 64 + lane;
            const float* w = p.in[I_WMOD] + ((size_t)l * D + wave * 128) * NMOD * D + col;
            float a0 = 0.f, a1 = 0.f, a2 = 0.f, a3 = 0.f, a4 = 0.f;
#pragma unroll 8
            for (int k = 0; k < 128; ++k) { const float wv = w[(size_t)k * NMOD * D]; const int kk = wave * 128 + k;
                a0 += sc[kk] * wv; a1 += sc[D + kk] * wv; a2 += sc[2 * D + kk] * wv; a3 += sc[3 * D + kk] * wv; a4 += sc[4 * D + kk] * wv; }
            red[(wave * 5 + 0) * 64 + lane] = a0; red[(wave * 5 + 1) * 64 + lane] = a1; red[(wave * 5 + 2) * 64 + lane] = a2; red[(wave * 5 + 3) * 64 + lane] = a3; red[(wave * 5 + 4) * 64 + lane] = a4;
            __syncthreads();
            if (tid < 320) { const int r = tid >> 6; float sum = 0.f;
#pragma unroll
                for (int w2 = 0; w2 < 8; ++w2) sum += red[(w2 * 5 + r) * 64 + lane];
                ((float*)(p.ws + WS_MOD))[((size_t)(l * 5 + r)) * NMOD * D + col] = sum + p.in[I_BMOD][(size_t)l * NMOD * D + col]; }
            __syncthreads();
        }
        __syncthreads();
    }
    {
        float* scr = (float*)(lds + 32768) + wave * (64 * 33);
        constexpr int I_IN = 16 * 56, I_OUT = 16 * 32, I_UP = 16 * 176, I_DN = 44 * 32, I_L = I_IN + I_OUT + I_UP + I_DN;
        for (int it = gw; it < DEPTH * I_L; it += NGW) {
            const int l = it / I_L; int r = it % I_L;
            if (r < I_IN) { const int kb = r / 56, nb = r % 56; transpose_item(p.in[I_WIN] + (size_t)l * D * DIN, D, DIN, (bf16_t*)(p.ws + WS_WIN) + (size_t)l * DIN * D, nb * 32, nb * 32, kb * 64, scr, lane); continue; }
            r -= I_IN;
            if (r < I_OUT) { const int kb = r / 32, nb = r % 32; transpose_item(p.in[I_WOUT] + (size_t)l * D * D, D, D, (bf16_t*)(p.ws + WS_WOUT) + (size_t)l * D * D, nb * 32, nb * 32, kb * 64, scr, lane); continue; }
            r -= I_OUT;
            if (r < I_UP) { const int kb = r / 176, nb = r % 176; const int sn = nb * 32; const int isup = sn >= DFF ? 1 : 0; const int sj = sn - isup * DFF; const int dn = (sj / 128) * 256 + isup * 128 + (sj % 128);
                transpose_item(p.in[I_WUP] + (size_t)l * D * 2 * DFF, D, 2 * DFF, (bf16_t*)(p.ws + WS_WUP) + (size_t)l * 2 * DFF * D, sn, dn, kb * 64, scr, lane); continue; }
            r -= I_UP;
            { const int kb = r / 32, nb = r % 32; transpose_item(p.in[I_WDN] + (size_t)l * DFF * D, DFF, D, (bf16_t*)(p.ws + WS_WDN) + (size_t)l * D * DFF, nb * 32, nb * 32, kb * 64, scr, lane); }
        }
    }
    float* tab = (float*)(p.ws + WS_TAB);
    for (int j = gtid; j < 8192; j += GT_) { tab[j] = cospif((float)j / 4096.0f); tab[8192 + j] = sinpif((float)j / 4096.0f); }
    { bf16_t* TA = (bf16_t*)(p.ws + WS_TA);
      for (int i = gtid; i < 128 * 64; i += GT_) { const int l1 = i & 63, m = i >> 6, k1 = m >> 1, comp = m & 1; const float a = (float)((k1 * l1) & 63) / 32.0f; TA[i] = f2bf(comp ? -sinpif(a) : cospif(a)); } }
    bf16_t* T = (bf16_t*)(p.ws + WS_T);
    for (int i = gtid; i < 256 * 256; i += GT_) { const int m = i >> 8, kk = i & 255, k2 = m & 127, co = m >> 7, l2 = kk >> 1, ci = kk & 1; const float a = (float)((k2 * l2) & 127) / 64.0f;
        const float cv = cospif(a), sv = sinpif(a); T[i] = f2bf(co == 0 ? (ci == 0 ? cv : sv) : (ci == 0 ? -sv : cv)); }
    { bf16_t* WG = (bf16_t*)(p.ws + WS_WG);
      for (int i = gtid; i < 2 * DEPTH * 2 * 8 * 64 * 64; i += GT_) { const int c = i & 63, e = (i >> 6) & 63, ldh = (i >> 12) & 31, gsel = i >> 17;
          const float* src = (gsel ? p.in[I_WX] : p.in[I_WA]) + ((size_t)ldh * 64 + c) * 64 + e; WG[i] = f2bf(*src); } }
    { float* SM = (float*)(p.ws + WS_SM);
      for (int i = gtid; i < DEPTH * SM_PER_LAYER; i += GT_) { const int l = i / SM_PER_LAYER, o = i % SM_PER_LAYER; float v;
          if (o < SM_CONVB) v = p.in[I_CONVW][l * 2048 + o];
          else if (o < SM_BA) v = p.in[I_CONVB][l * 512 + o - SM_CONVB];
          else if (o < SM_BX) v = p.in[I_BA][l * 1024 + o - SM_BA];
          else if (o < SM_SP8) v = p.in[I_BX][l * 1024 + o - SM_BX];
          else if (o < SM_SGB) v = -8.0f * log1pf(expf(-p.in[I_LAM][l * 1024 + o - SM_SP8]));
          else if (o < SM_GMIX) v = p.in[I_SGB][l * 512 + o - SM_SGB];
          else if (o < SM_LN1G) v = p.in[I_GMIX][l * 1024 + o - SM_GMIX];
          else if (o < SM_LN1B) v = p.in[I_LN1G][l * 1024 + o - SM_LN1G];
          else if (o < SM_LN2G) v = p.in[I_LN1B][l * 1024 + o - SM_LN1B];
          else if (o < SM_LN2B) v = p.in[I_LN2G][l * 1024 + o - SM_LN2G];
          else v = p.in[I_LN2B][l * 1024 + o - SM_LN2B];
          SM[i] = v; }
      bf16_t* SGWB = (bf16_t*)(p.ws + WS_SGWB);
      for (int i = gtid; i < DEPTH * 4 * CHUNK * CHUNK; i += GT_) SGWB[i] = f2bf(p.in[I_SGW][i]);
      bf16_t* MMT = (bf16_t*)(p.ws + WS_MMT);
      for (int i = gtid; i < DEPTH * 4 * 64 * 128; i += GT_) { const int j = i & 127, e = (i >> 7) & 63, lh = i >> 13; const int cc = j >> 1, comp = j & 1;
          const float* wf = p.in[I_FW] + ((size_t)lh * 64) * 64 + e; float sum = 0.f;
          for (int m = 0; m < 64; ++m) { const float a = (float)((cc * m) & 63) / 32.0f; sum += (comp ? sinpif(a) : cospif(a)) * wf[m * 64]; }
          MMT[i] = f2bf(sum); } }
}

__device__ __forceinline__ void ln_stats(f32x4 (&v)[4], float& rstd) {
    float s = 0.f;
#pragma unroll
    for (int j = 0; j < 4; ++j) s += (v[j][0] + v[j][1]) + (v[j][2] + v[j][3]);
    const float mean = wave_sum(s) * (1.0f / D); float q = 0.f;
#pragma unroll
    for (int j = 0; j < 4; ++j) { v[j] = v[j] - mean; q += (v[j][0] * v[j][0] + v[j][1] * v[j][1]) + (v[j][2] * v[j][2] + v[j][3] * v[j][3]); }
    rstd = rsqrtf(wave_sum(q) * (1.0f / D) + LN_EPS);
}
__device__ __forceinline__ void lnmod_store(const Params& p, f32x4 (&v)[4], int l, int r, int shift_idx, int scale_idx, int lane) {
    float rstd; ln_stats(v, rstd);
    const f32x4* sh = (const f32x4*)mod_ptr(p, l, r, shift_idx) + lane; const f32x4* sc = (const f32x4*)mod_ptr(p, l, r, scale_idx) + lane;
    u32x2* o = (u32x2*)((bf16_t*)(p.ws + WS_XN) + (size_t)r * D) + lane;
#pragma unroll
    for (int j = 0; j < 4; ++j) { const f32x4 a = sc[64 * j], b = sh[64 * j]; f32x4 y = v[j] * rstd * (a + 1.0f) + b; u32x2 w; w.x = pk2(y[0], y[1]); w.y = pk2(y[2], y[3]); o[64 * j] = w; }
}
__device__ __forceinline__ void phase_lnmod0(const Params& p, int wv) {
    const int lane = opaque_lane(), gw = blockIdx.x * NWAVE + wv, NGW = gridDim.x * NWAVE;
    for (int t = gw; t < SEQ; t += NGW) {
        f32x4 pe[4];
#pragma unroll
        for (int k = 0; k < 4; ++k) { const float freq = exp2f(-(float)(4 * lane + k) * (13.287712379549449f / 256.0f)) * 0.3183098861837907f; const float ar = (float)(t / 64) * freq, ac = (float)(t % 64) * freq;
            pe[0][k] = sinpif(ar); pe[1][k] = cospif(ar); pe[2][k] = sinpif(ac); pe[3][k] = cospif(ac); }
        f32x4 xa[NB][4];
#pragma unroll
        for (int b = 0; b < NB; ++b) { const f32x4* xr = (const f32x4*)(p.in[I_X] + (size_t)(b * SEQ + t) * D) + lane;
#pragma unroll
            for (int j = 0; j < 4; ++j) xa[b][j] = xr[64 * j]; }
#pragma unroll
        for (int b = 0; b < NB; ++b) { const int r = b * SEQ + t; f32x4* xo = (f32x4*)(p.out + (size_t)r * D) + lane; f32x4 v[4];
#pragma unroll
            for (int j = 0; j < 4; ++j) { v[j] = xa[b][j] + pe[j]; xo[64 * j] = v[j]; }
            lnmod_store(p, v, 0, r, 0, 1, lane); }
    }
    for (int rc = gw; rc < NCTX; rc += NGW) { const int r = NLAT + rc; const f32x4* xr = (const f32x4*)(p.in[I_CTX] + (size_t)rc * D) + lane; f32x4* xo = (f32x4*)(p.ws + WS_XCTX + (size_t)rc * D * 4) + lane; f32x4 v[4];
#pragma unroll
        for (int j = 0; j < 4; ++j) { v[j] = xr[64 * j]; xo[64 * j] = v[j]; }
        lnmod_store(p, v, 0, r, 0, 1, lane); }
}
__device__ __forceinline__ void wave_sum2(float& a, float& b) {
#pragma unroll
    for (int o = 1; o < 64; o <<= 1) { const float ta = __shfl_xor(a, o), tb = __shfl_xor(b, o); a += ta; b += tb; }
}
__device__ __forceinline__ void phase_ln(const Params& p, int nrows, const float* g, const float* b, int l, int gate_idx, int nl, int shift_idx, int scale_idx, int wv, int dry) {
    const int lane = opaque_lane(), gw = blockIdx.x * NWAVE + wv, NGW = gridDim.x * NWAVE;
    const bf16_t* T = (const bf16_t*)(p.ws + WS_XN);
    f32x4 gg[4], bb[4], gv[4], shv[4], scv[4];
#pragma unroll
    for (int j = 0; j < 4; ++j) { gg[j] = ((const f32x4*)g)[lane + 64 * j]; bb[j] = ((const f32x4*)b)[lane + 64 * j]; gv[j] = shv[j] = scv[j] = (f32x4){0.f, 0.f, 0.f, 0.f}; }
    int cur_mrow = -1;
    f32x4 xn_[2][4]; u32x2 tn_[2][4];
#pragma unroll
    for (int u = 0; u < 2; ++u) { const int r = 2 * gw + u; const int rr = r < nrows ? r : 0; const f32x4* xr = (const f32x4*)xrow_ptr(p, rr) + lane; const u32x2* tr = (const u32x2*)(T + (size_t)rr * D) + lane;
#pragma unroll
        for (int j = 0; j < 4; ++j) { xn_[u][j] = __builtin_nontemporal_load(xr + 64 * j); tn_[u][j] = __builtin_nontemporal_load(tr + 64 * j); } }
    for (int r0 = 2 * gw; r0 < nrows; r0 += 2 * NGW) {
        const int rr[2] = {r0, r0 + 1};
        f32x4 v[2][4]; u32x2 t[2][4];
#pragma unroll
        for (int u = 0; u < 2; ++u)
#pragma unroll
            for (int j = 0; j < 4; ++j) { v[u][j] = xn_[u][j]; t[u][j] = tn_[u][j]; }
#pragma unroll
        for (int u = 0; u < 2; ++u) { const int rn = r0 + 2 * NGW + u; const int rq = rn < nrows ? rn : 0; const f32x4* xr = (const f32x4*)xrow_ptr(p, rq) + lane; const u32x2* tr = (const u32x2*)(T + (size_t)rq * D) + lane;
#pragma unroll
            for (int j = 0; j < 4; ++j) { xn_[u][j] = __builtin_nontemporal_load(xr + 64 * j); tn_[u][j] = __builtin_nontemporal_load(tr + 64 * j); } }
        const int mr = mod_row(r0);
        if (mr != cur_mrow) {
            cur_mrow = mr;
            const f32x4* gt = (const f32x4*)mod_ptr(p, l, r0, gate_idx) + lane;
#pragma unroll
            for (int j = 0; j < 4; ++j) gv[j] = gt[64 * j];
            if (nl >= 0) { const f32x4* sh = (const f32x4*)mod_ptr(p, nl, r0, shift_idx) + lane; const f32x4* sc = (const f32x4*)mod_ptr(p, nl, r0, scale_idx) + lane;
#pragma unroll
                for (int j = 0; j < 4; ++j) { shv[j] = sh[64 * j]; scv[j] = sc[64 * j] + 1.0f; } }
        }
        float s[2];
#pragma unroll
        for (int u = 0; u < 2; ++u) { s[u] = 0.f;
#pragma unroll
            for (int j = 0; j < 4; ++j) { f32x4 tv; tv[0] = __builtin_bit_cast(float, t[u][j].x << 16); tv[1] = __builtin_bit_cast(float, t[u][j].x & 0xffff0000u); tv[2] = __builtin_bit_cast(float, t[u][j].y << 16); tv[3] = __builtin_bit_cast(float, t[u][j].y & 0xffff0000u);
                v[u][j] = v[u][j] * ALPHA + gv[j] * tv; s[u] += (v[u][j][0] + v[u][j][1]) + (v[u][j][2] + v[u][j][3]); } }
        wave_sum2(s[0], s[1]);
        float q[2];
#pragma unroll
        for (int u = 0; u < 2; ++u) { const float mean = s[u] * (1.0f / D); q[u] = 0.f;
#pragma unroll
            for (int j = 0; j < 4; ++j) { v[u][j] = v[u][j] - mean; q[u] += (v[u][j][0] * v[u][j][0] + v[u][j][1] * v[u][j][1]) + (v[u][j][2] * v[u][j][2] + v[u][j][3] * v[u][j][3]); } }
        wave_sum2(q[0], q[1]);
#pragma unroll
        for (int u = 0; u < 2; ++u) { const float rstd = rsqrtf(q[u] * (1.0f / D) + LN_EPS); f32x4* xr = (f32x4*)xrow_ptr(p, rr[u]) + lane;
#pragma unroll
            for (int j = 0; j < 4; ++j) { v[u][j] = v[u][j] * rstd * gg[j] + bb[j]; __builtin_nontemporal_store(v[u][j], xr + 64 * j); } }
        if (nl >= 0) {
#pragma unroll
            for (int u = 0; u < 2; ++u) { s[u] = 0.f;
#pragma unroll
                for (int j = 0; j < 4; ++j) s[u] += (v[u][j][0] + v[u][j][1]) + (v[u][j][2] + v[u][j][3]); }
            wave_sum2(s[0], s[1]);
#pragma unroll
            for (int u = 0; u < 2; ++u) { const float mean = s[u] * (1.0f / D); q[u] = 0.f;
#pragma unroll
                for (int j = 0; j < 4; ++j) { v[u][j] = v[u][j] - mean; q[u] += (v[u][j][0] * v[u][j][0] + v[u][j][1] * v[u][j][1]) + (v[u][j][2] * v[u][j][2] + v[u][j][3] * v[u][j][3]); } }
            wave_sum2(q[0], q[1]);
#pragma unroll
            for (int u = 0; u < 2; ++u) { const float rstd = rsqrtf(q[u] * (1.0f / D) + LN_EPS); u32x2* o = (u32x2*)((bf16_t*)(p.ws + WS_XN) + (size_t)rr[u] * D) + lane;
#pragma unroll
                for (int j = 0; j < 4; ++j) { const f32x4 y = v[u][j] * rstd * scv[j] + shv[j]; u32x2 w; w.x = pk2(y[0], y[1]); w.y = pk2(y[2], y[3]); o[64 * j] = w; } }
        }
    }
}

__device__ __forceinline__ void chunk_info(int cidx, int& r0, int& s0, int& L) {
    r0 = cidx * CHUNK;
    if (cidx < NLAT / CHUNK) { s0 = (cidx >> 6) * SEQ; L = SEQ; } else { s0 = NLAT + ((cidx - NLAT / CHUNK) >> 1) * CTX; L = CTX; }
}
__device__ __forceinline__ float sigmoid_fast(float v) { return __builtin_amdgcn_rcpf(1.0f + __builtin_amdgcn_exp2f(-1.44269504089f * v)); }
__device__ __forceinline__ float gelu_fast(float v) {
    const float av = fabsf(v), t = __builtin_amdgcn_rcpf(av * 0.2316418882f + 1.0f);
    float q = t * 0.5307027145f + (-0.7265760135f); q = q * t + 0.7107068705f; q = q * t + (-0.142248368f); q = q * t + 0.127414796f; q = q * t;
    const float e = __builtin_amdgcn_exp2f((v * v) * (-0.72134752044f)); const float m = v * (q * e);
    return v < 0.f ? m : v - m;
}

template <int DIR>
__device__ __forceinline__ void scan_item(const Params& p, int l, int cidx, int h, float* wl, int lane) {
    int r0, s0, L; chunk_info(cidx, r0, s0, L); const int t0 = r0 - s0;
    const int ch = h * 64 + lane;
    const bf16_t* P = (const bf16_t*)(p.ws + WS_P);
    const float* sm = (const float*)(p.ws + WS_SM) + (size_t)l * SM_PER_LAYER;
    const float* cw = sm + SM_CONVW + ch; const float cw0 = cw[0], cw1 = cw[DA], cw2 = cw[2 * DA], cw3 = cw[3 * DA], cb = sm[SM_CONVB + ch];
    const float ba = sm[SM_BA + DIR * DA + ch], bx = sm[SM_BX + DIR * DA + ch], sp8 = sm[SM_SP8 + DIR * DA + ch];
    pg8::bf16x8 wfa[4][2], wfx[4][2];
    { const bf16_t* wga = (const bf16_t*)(p.ws + WS_WG) + (((size_t)(l * 2 + DIR) * 8 + h) * 64) * 64; const bf16_t* wgx = wga + (size_t)DEPTH * 2 * 8 * 64 * 64;
#pragma unroll
      for (int nt = 0; nt < 4; ++nt)
#pragma unroll
          for (int ks = 0; ks < 2; ++ks) { const int o = (16 * nt + (lane & 15)) * 64 + 32 * ks + 8 * (lane >> 4); wfa[nt][ks] = *(const pg8::bf16x8*)(wga + o); wfx[nt][ks] = *(const pg8::bf16x8*)(wgx + o); } }
    float* zaL = wl + 16 * 68; float* zxL = wl + 32 * 68;
    float* agg = (float*)(p.ws + WS_AGG);
    float hst = 0.f, Ap = 1.f;
    const __amdgpu_buffer_rsrc_t hrs = __builtin_amdgcn_make_buffer_rsrc(p.ws, 0, 0x7fffffff, 0x00020000); const unsigned hbase = (unsigned)(DIR == 0 ? WS_HF : WS_AF) + (unsigned)(r0 * DA + ch) * 4u;
    bf16_t xn[19];
    const unsigned pvo = (unsigned)WS_P + (unsigned)ch * 2u;
    { const int s = DIR ? 7 : 0; const int tb = t0 + 16 * s - 2;
#pragma unroll
      for (int i = 0; i < 19; ++i) { int tc = tb + i; tc = tc < 0 ? 0 : tc; tc = tc > L - 1 ? L - 1 : tc; xn[i] = __builtin_amdgcn_raw_buffer_load_b16(hrs, (int)pvo, (s0 + tc) * (DIN * 2), 0); } }
#pragma unroll 1
    for (int si = 0; si < 8; ++si) {
        const int s = DIR ? 7 - si : si;
        float xw[19];
#pragma unroll
        for (int i = 0; i < 19; ++i) { const int t = t0 + 16 * s - 2 + i; const float okf = (t >= 0 && t < L) ? 1.0f : 0.0f; xw[i] = bf2f(xn[i]) * okf; }
        if (si < 7) { const int s2 = DIR ? 6 - si : si + 1; const int tb = t0 + 16 * s2 - 2;
#pragma unroll
            for (int i = 0; i < 19; ++i) { int tc = tb + i; tc = tc < 0 ? 0 : tc; tc = tc > L - 1 ? L - 1 : tc; xn[i] = __builtin_amdgcn_raw_buffer_load_b16(hrs, (int)pvo, (s0 + tc) * (DIN * 2), 0); } }
#pragma unroll
        for (int tt = 0; tt < 16; ++tt) wl[tt * 68 + lane] = cb + cw0 * xw[tt] + cw1 * xw[tt + 1] + cw2 * xw[tt + 2] + cw3 * xw[tt + 3];
        asm volatile("s_waitcnt lgkmcnt(0)" ::: "memory");
        {
            pg8::bf16x8 af[2];
#pragma unroll
            for (int ks = 0; ks < 2; ++ks) { const float* xp = wl + (lane & 15) * 68 + 32 * ks + 8 * (lane >> 4); const f32x4 x0 = *(const f32x4*)xp, x1 = *(const f32x4*)(xp + 4);
                const unsigned w0 = pk2(x0[0], x0[1]), w1 = pk2(x0[2], x0[3]), w2 = pk2(x1[0], x1[1]), w3 = pk2(x1[2], x1[3]);
                u32x4 t; t.x = w0; t.y = w1; t.z = w2; t.w = w3; af[ks] = __builtin_bit_cast(pg8::bf16x8, t); }
#pragma unroll
            for (int nt = 0; nt < 4; ++nt) { pg8::f32x4 ca = {0.f, 0.f, 0.f, 0.f}, cx = {0.f, 0.f, 0.f, 0.f};
#pragma unroll
                for (int ks = 0; ks < 2; ++ks) { ca = __builtin_amdgcn_mfma_f32_16x16x32_bf16(af[ks], wfa[nt][ks], ca, 0, 0, 0); cx = __builtin_amdgcn_mfma_f32_16x16x32_bf16(af[ks], wfx[nt][ks], cx, 0, 0, 0); }
#pragma unroll
                for (int rg_ = 0; rg_ < 4; ++rg_) { const int o = (4 * (lane >> 4) + rg_) * 68 + 16 * nt + (lane & 15); zaL[o] = ca[rg_]; zxL[o] = cx[rg_]; } }
        }
        asm volatile("s_waitcnt lgkmcnt(0)" ::: "memory");
#pragma unroll
        for (int ti = 0; ti < 16; ti += 2) {
            typedef float f32x2 __attribute__((ext_vector_type(2)));
            const int ta_ = DIR ? 15 - ti : ti, tb_ = DIR ? 14 - ti : ti + 1;
            const f32x2 za = (f32x2){zaL[ta_ * 68 + lane], zaL[tb_ * 68 + lane]} + ba, zx = (f32x2){zxL[ta_ * 68 + lane], zxL[tb_ * 68 + lane]} + bx;
            const f32x2 xo = (f32x2){wl[ta_ * 68 + lane], wl[tb_ * 68 + lane]};
            const f32x2 ea = za * (-1.44269504089f), ex = zx * (-1.44269504089f);
            f32x2 da, dx; da.x = __builtin_amdgcn_exp2f(ea.x); da.y = __builtin_amdgcn_exp2f(ea.y); dx.x = __builtin_amdgcn_exp2f(ex.x); dx.y = __builtin_amdgcn_exp2f(ex.y);
            da = da + 1.0f; dx = dx + 1.0f;
            f32x2 rg, ig; rg.x = __builtin_amdgcn_rcpf(da.x); rg.y = __builtin_amdgcn_rcpf(da.y); ig.x = __builtin_amdgcn_rcpf(dx.x); ig.y = __builtin_amdgcn_rcpf(dx.y);
            const f32x2 la = rg * (sp8 * 1.44269504089f);
            f32x2 a; a.x = __builtin_amdgcn_exp2f(la.x); a.y = __builtin_amdgcn_exp2f(la.y);
            const f32x2 om = 1.0f - a * a;
            f32x2 sq; sq.x = __builtin_amdgcn_sqrtf(om.x); sq.y = __builtin_amdgcn_sqrtf(om.y);
            const f32x2 u = sq * (ig * xo);
            hst = a.x * hst + u.x; Ap *= a.x; __builtin_amdgcn_raw_buffer_store_b32(pg8::cvt_pk_bf16(hst, Ap), hrs, (int)(hbase + (unsigned)(16 * s * DA) * 4u), ta_ * DA * 4, 0);
            hst = a.y * hst + u.y; Ap *= a.y; __builtin_amdgcn_raw_buffer_store_b32(pg8::cvt_pk_bf16(hst, Ap), hrs, (int)(hbase + (unsigned)(16 * s * DA) * 4u), tb_ * DA * 4, 0);
        }
        asm volatile("s_waitcnt lgkmcnt(0)" ::: "memory");
    }
    { float* a = agg + ((size_t)cidx * 2 + DIR) * 2 * DA + ch; a[0] = Ap; a[DA] = hst; }
}

__device__ __forceinline__ void phase_mix1(const Params& p, int l, unsigned char* lds, int wv, int mode) {
    const int tid = opaque_tid(wv), lane = tid & 63, wave = tid >> 6, bid = blockIdx.x, G = gridDim.x;
    const int gw = bid * NWAVE + wave, NGW = G * NWAVE; const bool last = (l == DEPTH - 1);
    const bf16_t* P = (const bf16_t*)(p.ws + WS_P);
    if (mode & 1) { float* wl = (float*)lds + wave * 3264;
      const int nrounds = p.sc_rounds, nextra = p.sc_nextra, esh = p.sc_esh;
      for (int k = 0; k <= nrounds; ++k) { int it;
          if (k < nrounds) it = gw + k * NGW; else { const int e = gw >> esh; if (nextra == 0 || (e << esh) != gw || e >= nextra) break; it = nrounds * NGW + e; }
          const int cidx = it >> 4, d = (it >> 3) & 1, h = it & 7;
          if (d == 0) scan_item<0>(p, l, cidx, h, wl, lane); else scan_item<1>(p, l, cidx, h, wl, lane); } }
    __syncthreads();
    const float* tab = (const float*)(p.ws + WS_TAB); bf16_t* GT = (bf16_t*)(p.ws + WS_GT);
    if (!(mode & 2)) return;
    { bf16_t* zt = (bf16_t*)lds; constexpr int ZK = 72;
      const bf16_t* TA = (const bf16_t*)(p.ws + WS_TA);
      for (int it = bid; it < NB * 64; it += G) { const int b = it >> 6, lb = (it >> 2) & 15, cq = it & 3;
          { const int l1 = tid >> 3, l2i = tid & 7; const u32x4* src = (const u32x4*)(P + (size_t)(b * SEQ + l1 * 128 + lb * 8 + l2i) * DIN + 2 * DA + 2 * DB + cq * 64);
            u32x4 w[8];
#pragma unroll
            for (int j = 0; j < 8; ++j) w[j] = src[j];
#pragma unroll
            for (int j = 0; j < 8; ++j) { const unsigned ww[4] = {w[j].x, w[j].y, w[j].z, w[j].w};
#pragma unroll
                for (int e = 0; e < 4; ++e) { const int chl = j * 8 + 2 * e; zt[(chl * 8 + l2i) * ZK + l1] = (bf16_t)(ww[e] & 0xffffu); zt[((chl + 1) * 8 + l2i) * ZK + l1] = (bf16_t)(ww[e] >> 16); } } }
          __syncthreads();
          { int ln = lane; asm volatile("" : "+v"(ln)); const int fr = ln & 15, fq = ln >> 4;
            pg8::bf16x8 ta[8][2];
#pragma unroll
            for (int mt = 0; mt < 8; ++mt)
#pragma unroll
                for (int ks = 0; ks < 2; ++ks) ta[mt][ks] = *(const pg8::bf16x8*)(TA + (16 * mt + fr) * 64 + 32 * ks + 8 * fq);
#pragma unroll 1
            for (int nt = 0; nt < 4; ++nt) { const int n0 = 64 * wave + 16 * nt;
                const pg8::bf16x8 b0 = *(const pg8::bf16x8*)(zt + (n0 + fr) * ZK + 8 * fq), b1 = *(const pg8::bf16x8*)(zt + (n0 + fr) * ZK + 32 + 8 * fq);
                const int chl = (n0 + fr) >> 3, l2 = lb * 8 + (fr & 7);
                bf16_t* gbase = GT + ((size_t)(b * 64) * 256 + cq * 64 + chl) * 256 + 2 * l2;
#pragma unroll
                for (int mt = 0; mt < 8; ++mt) { pg8::f32x4 acc = {0.f, 0.f, 0.f, 0.f};
                    acc = __builtin_amdgcn_mfma_f32_16x16x32_bf16(ta[mt][0], b0, acc, 0, 0, 0); acc = __builtin_amdgcn_mfma_f32_16x16x32_bf16(ta[mt][1], b1, acc, 0, 0, 0);
#pragma unroll
                    for (int pr = 0; pr < 2; ++pr) { const int k1 = 8 * mt + 2 * fq + pr; const float gr = acc[2 * pr], gi = acc[2 * pr + 1]; const int ix = k1 * l2;
                        const float cs = tab[ix], sn = tab[8192 + ix];
                        *(unsigned*)(gbase + (size_t)k1 * 256 * 256) = pk2(gr * cs + gi * sn, gi * cs - gr * sn); } } } }
          __syncthreads();
      } }
    if (!last) {
        for (int i = bid * NTHR + tid; i < NB * 128 * 256; i += G * NTHR) { const int ch = i & 255, l2 = (i >> 8) & 127, b = i >> 15;
            const float z0 = bf2f(P[(size_t)(NLAT + b * CTX + l2) * DIN + 2 * DA + 2 * DB + ch]), z1 = bf2f(P[(size_t)(NLAT + b * CTX + 128 + l2) * DIN + 2 * DA + 2 * DB + ch]);
            const float g0 = z0 + z1, g1 = z0 - z1; const float c1 = tab[l2 * 32], s1 = tab[8192 + l2 * 32];
            *(unsigned*)(GT + ((size_t)((256 + b * 2 + 0) * 256 + ch)) * 256 + 2 * l2) = pk2(g0, 0.f);
            *(unsigned*)(GT + ((size_t)((256 + b * 2 + 1) * 256 + ch)) * 256 + 2 * l2) = pk2(g1 * c1, -g1 * s1); }
    }
}


__device__ __forceinline__ void phase_carry(const Params& p, int wv) {
    const int G = gridDim.x, k = (int)blockIdx.x - (G - 8); if (k < 0) return;
    const int ch = opaque_tid(wv), b = k >> 1, d = k & 1;
    const float* agg = (const float*)(p.ws + WS_AGG); float* car = (float*)(p.ws + WS_CARRY);
    const int cbase = NLAT / CHUNK + 2 * b, lbase = b * 64; float h = 0.f;
    if (d == 0) {
#pragma unroll
        for (int j = 0; j < 2; ++j) { const int c = cbase + j; const float* a = agg + ((size_t)c * 2 + 0) * 2 * DA + ch; car[((size_t)c * 2 + 0) * DA + ch] = h; h = a[0] * h + a[DA]; }
#pragma unroll 32
        for (int j = 0; j < 64; ++j) { const int c = lbase + j; const float* a = agg + ((size_t)c * 2 + 0) * 2 * DA + ch; car[((size_t)c * 2 + 0) * DA + ch] = h; h = a[0] * h + a[DA]; }
    } else {
#pragma unroll
        for (int j = 1; j >= 0; --j) { const int c = cbase + j; const float* a = agg + ((size_t)c * 2 + 1) * 2 * DA + ch; car[((size_t)c * 2 + 1) * DA + ch] = h; h = a[0] * h + a[DA]; }
#pragma unroll 32
        for (int j = 63; j >= 0; --j) { const int c = lbase + j; const float* a = agg + ((size_t)c * 2 + 1) * 2 * DA + ch; car[((size_t)c * 2 + 1) * DA + ch] = h; h = a[0] * h + a[DA]; }
    }
}

struct EpiDftB {
    static constexpr bool PERM = false, AFTER_DRAIN = false;
    bf16_t* V;
    __device__ __forceinline__ void operator()(const pg8::f32x4 (&acc)[2][2][4][2], const pg8::Unit& u, int wr, int wc, int fr, int fq) const {
        const int item = u.pn; int tok0, n1; float scale;
        if (item < 256) { tok0 = (item >> 6) * SEQ + (item & 63); n1 = 64; scale = 0.00138106793f;   }
        else { const int j = item - 256; tok0 = NLAT + (j >> 1) * CTX + (j & 1); n1 = 2; scale = 0.0078125f;   }
        const int ch0 = wc * 32 + 4 * fq;
#pragma unroll
        for (int m = 0; m < 4; ++m) { const int k2 = wr * 64 + m * 16 + fr; bf16_t* rowp = V + (size_t)(tok0 + n1 * k2) * 512 + 2 * ch0;
#pragma unroll
            for (int bj = 0; bj < 2; ++bj)
#pragma unroll
                for (int n = 0; n < 2; ++n) { const pg8::f32x4 re = acc[0][bj][m][n] * scale, im = acc[1][bj][m][n] * scale;
                    pg8::u32x4 w; w.x = pk2(re[0], im[0]); w.y = pk2(re[1], im[1]); w.z = pk2(re[2], im[2]); w.w = pk2(re[3], im[3]);
                    *(pg8::u32x4*)(rowp + 2 * (bj * 128 + n * 16)) = w; } }
    }
};

__device__ __forceinline__ void phase_mix3(const Params& p, int l, unsigned char* lds, int wv, int mode) {
    const int tid = opaque_tid(wv), lane = tid & 63, wave = tid >> 6, bid = blockIdx.x, G = gridDim.x;
    const bool last = (l == DEPTH - 1);
    const int nchunk = last ? NLAT / CHUNK : NCHUNK;
    constexpr int VQ = 136;
    bf16_t* vt = (bf16_t*)lds;
    bf16_t* mt = vt + 4 * 64 * VQ;
    const bf16_t* P = (const bf16_t*)(p.ws + WS_P); const unsigned* HAF = (const unsigned*)(p.ws + WS_HF); const unsigned* HAB = (const unsigned*)(p.ws + WS_AF);
    const float* car = (const float*)(p.ws + WS_CARRY);
    const bf16_t* V = (const bf16_t*)(p.ws + WS_V); bf16_t* Y = (bf16_t*)(p.ws + WS_Y);
    const bf16_t* WsB = (const bf16_t*)(p.ws + WS_SGWB) + (size_t)l * 4 * CHUNK * CHUNK; const bf16_t* MMT = (const bf16_t*)(p.ws + WS_MMT) + (size_t)l * 4 * 64 * 128;
    const float* sm = (const float*)(p.ws + WS_SM) + (size_t)l * SM_PER_LAYER; const float* gm = sm + SM_GMIX; const float* bsb = sm + SM_SGB;
    for (int i = tid; i < 4 * 64 * 16; i += NTHR) { const int row = i >> 4, c8 = (i & 15) * 8; *(u32x4*)(mt + row * VQ + c8) = *(const u32x4*)(MMT + (size_t)row * 128 + c8); }
    for (int cidx = bid; cidx < nchunk; cidx += G) {
        const int r0 = cidx * CHUNK, rw = r0 + 16 * wave;
#pragma unroll 1
        for (int pass = 0; pass < 2; ++pass) {
        if (pass == (bid & 1)) {
        pg8::bf16x8 wfr[16], vfr[16];
        { int ln = lane; asm volatile("" : "+v"(ln)); const int fr = ln & 15, fq = ln >> 4, prow = 16 * wave + fr;
#pragma unroll
          for (int h = 0; h < 4; ++h)
#pragma unroll
              for (int ks = 0; ks < 4; ++ks) { wfr[h * 4 + ks] = *(const pg8::bf16x8*)(WsB + ((size_t)(h * CHUNK + prow)) * CHUNK + 32 * ks + 8 * fq);
                  vfr[h * 4 + ks] = *(const pg8::bf16x8*)(V + (size_t)(r0 + prow) * 512 + h * 128 + 32 * ks + 8 * fq); } }
        if (mode & 1) { u32x2 vr[16];
#pragma unroll
          for (int i = 0; i < 16; ++i) vr[i] = *(const u32x2*)(P + (size_t)(rw + i) * DIN + 2 * DA + DB + lane * 4);
#pragma unroll
          for (int i = 0; i < 16; ++i) { float v0 = gelu_fast(__builtin_bit_cast(float, vr[i].x << 16)), v1 = gelu_fast(__builtin_bit_cast(float, vr[i].x & 0xffff0000u)), v2 = gelu_fast(__builtin_bit_cast(float, vr[i].y << 16)), v3 = gelu_fast(__builtin_bit_cast(float, vr[i].y & 0xffff0000u));
              float sm_ = (v0 + v1) + (v2 + v3); sm_ += __shfl_xor(sm_, 1); sm_ += __shfl_xor(sm_, 2); sm_ += __shfl_xor(sm_, 4); sm_ += __shfl_xor(sm_, 8);
              const float mean = sm_ * (1.0f / 64.0f); v0 -= mean; v1 -= mean; v2 -= mean; v3 -= mean;
              float q_ = (v0 * v0 + v1 * v1) + (v2 * v2 + v3 * v3); q_ += __shfl_xor(q_, 1); q_ += __shfl_xor(q_, 2); q_ += __shfl_xor(q_, 4); q_ += __shfl_xor(q_, 8);
              const float rstd = rsqrtf(q_ * (1.0f / 64.0f) + LN_EPS); bf16_t* vp = vt + (lane * 4) * VQ + 16 * wave + i;
              vp[0] = f2bf(v0 * rstd); vp[VQ] = f2bf(v1 * rstd); vp[2 * VQ] = f2bf(v2 * rstd); vp[3 * VQ] = f2bf(v3 * rstd); } }
        __syncthreads();
        pg8::f32x4 acc[16];
        if (mode & 2) { int ln = lane; asm volatile("" : "+v"(ln)); const int fr = ln & 15, fq = ln >> 4, prow = 16 * wave + fr; bf16_t* yr = Y + (size_t)(r0 + prow) * D;
#pragma unroll
        for (int i = 0; i < 16; ++i) acc[i] = (pg8::f32x4){0.f, 0.f, 0.f, 0.f};
#pragma unroll
        for (int h = 0; h < 4; ++h)
#pragma unroll
            for (int ks = 0; ks < 4; ++ks) { const pg8::bf16x8 bfr = wfr[h * 4 + ks];
#pragma unroll
                for (int nt = 0; nt < 4; ++nt) { const pg8::bf16x8 afr = *(const pg8::bf16x8*)(vt + (h * 64 + 16 * nt + fr) * VQ + 32 * ks + 8 * fq);
                    acc[h * 4 + nt] = __builtin_amdgcn_mfma_f32_16x16x32_bf16(afr, bfr, acc[h * 4 + nt], 0, 0, 0); }
                if (ks == 3) asm volatile("" ::: "memory"); }
        { float s2 = 0.f;
#pragma unroll
          for (int h = 0; h < 4; ++h) { const float bsv = bsb[h * CHUNK + prow];
#pragma unroll
              for (int nt = 0; nt < 4; ++nt) { const u32x2 uw = *(const u32x2*)(P + (size_t)(r0 + prow) * DIN + 2 * DA + h * 64 + 16 * nt + 4 * fq);
                  const float u0 = __builtin_bit_cast(float, uw.x << 16), u1 = __builtin_bit_cast(float, uw.x & 0xffff0000u), u2 = __builtin_bit_cast(float, uw.y << 16), u3 = __builtin_bit_cast(float, uw.y & 0xffff0000u);
                  pg8::f32x4 y; y[0] = gelu_fast(u0) * (acc[h * 4 + nt][0] + bsv); y[1] = gelu_fast(u1) * (acc[h * 4 + nt][1] + bsv); y[2] = gelu_fast(u2) * (acc[h * 4 + nt][2] + bsv); y[3] = gelu_fast(u3) * (acc[h * 4 + nt][3] + bsv);
                  acc[h * 4 + nt] = y; s2 += (y[0] * y[0] + y[1] * y[1]) + (y[2] * y[2] + y[3] * y[3]); } }
          s2 += __shfl_xor(s2, 16); s2 += __shfl_xor(s2, 32);
          const float rb = rsqrtf(s2 * (1.0f / DB) + LN_EPS);
#pragma unroll
          for (int i = 0; i < 16; ++i) { const int col = DA + (i >> 2) * 64 + 16 * (i & 3) + 4 * fq; const f32x4 g4 = *(const f32x4*)(gm + col);
              u32x2 o; o.x = pk2(acc[i][0] * rb * g4[0], acc[i][1] * rb * g4[1]); o.y = pk2(acc[i][2] * rb * g4[2], acc[i][3] * rb * g4[3]); *(u32x2*)(yr + col) = o; } } }
        asm volatile("" ::: "memory");
        if (mode & 4) { int ln = lane; asm volatile("" : "+v"(ln)); const int fr = ln & 15, fq = ln >> 4, prow = 16 * wave + fr; bf16_t* yr = Y + (size_t)(r0 + prow) * D;
#pragma unroll
        for (int i = 0; i < 16; ++i) acc[i] = (pg8::f32x4){0.f, 0.f, 0.f, 0.f};
#pragma unroll
        for (int h = 0; h < 4; ++h)
#pragma unroll
            for (int ks = 0; ks < 4; ++ks) { const pg8::bf16x8 bfr = vfr[h * 4 + ks];
#pragma unroll
                for (int nt = 0; nt < 4; ++nt) { const pg8::bf16x8 afr = *(const pg8::bf16x8*)(mt + (h * 64 + 16 * nt + fr) * VQ + 32 * ks + 8 * fq);
                    acc[h * 4 + nt] = __builtin_amdgcn_mfma_f32_16x16x32_bf16(afr, bfr, acc[h * 4 + nt], 0, 0, 0); }
                if (ks == 3) asm volatile("" ::: "memory"); }
        { float s2 = 0.f;
#pragma unroll
          for (int i = 0; i < 16; ++i) s2 += (acc[i][0] * acc[i][0] + acc[i][1] * acc[i][1]) + (acc[i][2] * acc[i][2] + acc[i][3] * acc[i][3]);
          s2 += __shfl_xor(s2, 16); s2 += __shfl_xor(s2, 32);
          const float rc = rsqrtf(s2 * (1.0f / DC) + LN_EPS);
#pragma unroll
          for (int i = 0; i < 16; ++i) { const int col = DA + DB + (i >> 2) * 64 + 16 * (i & 3) + 4 * fq; const f32x4 g4 = *(const f32x4*)(gm + col);
              u32x2 o; o.x = pk2(acc[i][0] * rc * g4[0], acc[i][1] * rc * g4[1]); o.y = pk2(acc[i][2] * rc * g4[2], acc[i][3] * rc * g4[3]); *(u32x2*)(yr + col) = o; } } }
        asm volatile("" ::: "memory");
        } else {
        if (mode & 8) { float cf[8], cbk[8];
#pragma unroll
          for (int k = 0; k < 8; ++k) { cf[k] = car[((size_t)cidx * 2 + 0) * DA + lane * 8 + k]; cbk[k] = car[((size_t)cidx * 2 + 1) * DA + lane * 8 + k]; }
#pragma unroll 4
        for (int i = 0; i < 16; ++i) { const int r = rw + i; float ya[8]; float sa2 = 0.f;
            const u32x4 gq = *(const u32x4*)(P + (size_t)r * DIN + DA + lane * 8);
            const u32x4 f0 = *(const u32x4*)(HAF + (size_t)r * DA + lane * 8), f1 = *(const u32x4*)(HAF + (size_t)r * DA + lane * 8 + 4), b0 = *(const u32x4*)(HAB + (size_t)r * DA + lane * 8), b1 = *(const u32x4*)(HAB + (size_t)r * DA + lane * 8 + 4);
            const unsigned gg[4] = {gq.x, gq.y, gq.z, gq.w}, ff[8] = {f0.x, f0.y, f0.z, f0.w, f1.x, f1.y, f1.z, f1.w}, bb[8] = {b0.x, b0.y, b0.z, b0.w, b1.x, b1.y, b1.z, b1.w};
#pragma unroll
            for (int k = 0; k < 4; ++k) { const float g0 = __builtin_bit_cast(float, gg[k] << 16), g1 = __builtin_bit_cast(float, gg[k] & 0xffff0000u);
                const float h0 = (__builtin_bit_cast(float, ff[2 * k] << 16) + __builtin_bit_cast(float, ff[2 * k] & 0xffff0000u) * cf[2 * k]) + (__builtin_bit_cast(float, bb[2 * k] << 16) + __builtin_bit_cast(float, bb[2 * k] & 0xffff0000u) * cbk[2 * k]);
                const float h1 = (__builtin_bit_cast(float, ff[2 * k + 1] << 16) + __builtin_bit_cast(float, ff[2 * k + 1] & 0xffff0000u) * cf[2 * k + 1]) + (__builtin_bit_cast(float, bb[2 * k + 1] << 16) + __builtin_bit_cast(float, bb[2 * k + 1] & 0xffff0000u) * cbk[2 * k + 1]);
                ya[2 * k] = gelu_fast(g0) * h0; ya[2 * k + 1] = gelu_fast(g1) * h1; sa2 += ya[2 * k] * ya[2 * k] + ya[2 * k + 1] * ya[2 * k + 1]; }
            const float ra = rsqrtf(wave_sum(sa2) * (1.0f / DA) + LN_EPS);
            const f32x4 g0 = *(const f32x4*)(gm + lane * 8), g1 = *(const f32x4*)(gm + lane * 8 + 4);
            u32x4 o; o.x = pk2(ya[0] * ra * g0[0], ya[1] * ra * g0[1]); o.y = pk2(ya[2] * ra * g0[2], ya[3] * ra * g0[3]); o.z = pk2(ya[4] * ra * g1[0], ya[5] * ra * g1[1]); o.w = pk2(ya[6] * ra * g1[2], ya[7] * ra * g1[3]);
            *(u32x4*)(Y + (size_t)r * D + lane * 8) = o; } }
        }
        }
        __syncthreads();
    }
}

constexpr int PH_PER_LAYER = 9, N_PHASES = 2 + PH_PER_LAYER * DEPTH;

#define XB_TMO      128
#define XB_XCNT(j)  (256  + 64 * (j))
#define XB_XSUB(j)  (1280 + 64 * (j))
#define XB_XGEN(j)  (2304 + 64 * (j))
#define XB_TOP      3328
#define XB_TOPGEN   3392
#define XCD_BAR_WORDS 3456
#define XB_SPIN_CAP (1u << 18)
__device__ __forceinline__ unsigned xb_ld(unsigned* p)              { return __hip_atomic_load(p, __ATOMIC_RELAXED, __HIP_MEMORY_SCOPE_AGENT); }
__device__ __forceinline__ unsigned xb_add(unsigned* p, unsigned v) { return __hip_atomic_fetch_add(p, v, __ATOMIC_RELAXED, __HIP_MEMORY_SCOPE_AGENT); }
__device__ __forceinline__ unsigned xb_xcc_id() { return (unsigned)__builtin_amdgcn_s_getreg((3 << 11) | 20) & 0xFu; }
#define XB_SPIN(cond, bar) do { unsigned _sp = 0; while (cond) { __builtin_amdgcn_s_sleep(1); \
    if ((++_sp & 255u) == 0u) { if (xb_ld(&(bar)[XB_TMO])) break; if (_sp > XB_SPIN_CAP) { atomicAdd(&(bar)[XB_TMO], 1u); break; } } } } while (0)
__device__ __forceinline__ void xcd_barrier_complete(unsigned* bar, unsigned x, unsigned& nloc, unsigned& nx) {
    const unsigned G = gridDim.x;
    unsigned sum, cnt, mine, sp = 0u;
    for (;;) {
        sum = 0u; cnt = 0u; mine = 0u;
#pragma unroll
        for (unsigned j = 0; j < 16; ++j) { const unsigned c = xb_ld(&bar[XB_XCNT(j)]); sum += c; cnt += (c > 0u) ? 1u : 0u; mine = (j == x) ? c : mine; }
        if (sum == G) break;
        __builtin_amdgcn_s_sleep(1);
        if ((++sp & 255u) == 0u) { if (xb_ld(&bar[XB_TMO])) break; if (sp > XB_SPIN_CAP) { atomicAdd(&bar[XB_TMO], 1u); break; } }
    }
    nloc = mine > 0u ? mine : 1u; nx = cnt > 0u ? cnt : 1u;
}
__device__ __forceinline__ void xcd_barrier(unsigned* bar, unsigned x, volatile PG8_LAS unsigned* st, bool t0) {
    asm volatile("s_waitcnt vmcnt(0)" ::: "memory");
    __syncthreads();
    if (t0) {
        __builtin_amdgcn_s_waitcnt(0);
        unsigned nloc = st[0], nx = st[1];
        if (nloc == 0u) { xcd_barrier_complete(bar, x, nloc, nx); st[0] = nloc; st[1] = nx; }
        const unsigned old = xb_add(&bar[XB_XSUB(x)], 1u);
        const unsigned gen = old / nloc;
        if (old + 1u == (gen + 1u) * nloc) {
            __builtin_amdgcn_fence(__ATOMIC_RELEASE, "agent");
            asm volatile("s_waitcnt vmcnt(0)" ::: "memory");
            const unsigned og = xb_add(&bar[XB_TOP], 1u);
            const unsigned tg = og / nx;
            if (og + 1u == (tg + 1u) * nx) xb_add(&bar[XB_TOPGEN], 1u);
            else XB_SPIN(xb_ld(&bar[XB_TOPGEN]) == tg, bar);
            __builtin_amdgcn_fence(__ATOMIC_ACQUIRE, "agent");
            xb_add(&bar[XB_XGEN(x)], 1u);
            asm volatile("s_waitcnt vmcnt(0)" ::: "memory");
        } else {
            XB_SPIN(xb_ld(&bar[XB_XGEN(x)]) == gen, bar);
            __builtin_amdgcn_fence(__ATOMIC_ACQUIRE, "agent");
            asm volatile("s_waitcnt vmcnt(0)" ::: "memory");
        }
    }
    __syncthreads();
}

__global__ void __launch_bounds__(NTHR, 2) mega(Params p) {
    extern __shared__ __attribute__((aligned(16))) unsigned char lds[];
    cg::grid_group grid = cg::this_grid();
    const int lo = p.ph_lo, hi = p.ph_hi, G = gridDim.x, bid = blockIdx.x;
    const int wv = __builtin_amdgcn_readfirstlane((int)(threadIdx.x >> 6));
    PG8_LAS unsigned char* gl = (PG8_LAS unsigned char*)lds;
#define IN(k) (lo <= (k) && (k) < hi)
    volatile PG8_LAS unsigned* xst = (volatile PG8_LAS unsigned*)(gl + LDS_BYTES - 16);
#define T0() ((wv == 0) && (opaque_lane() == 0))
    const unsigned xcc = xb_xcc_id();
    if (T0()) { xst[0] = 0u; xst[1] = 0u; (void)xb_add((unsigned*)(p.ws + WS_BAR) + XB_XCNT(xcc), 1u); }
    __syncthreads();
    if (hi < 0) grid.sync();
#define GBAR() xcd_barrier((unsigned*)(p.ws + WS_BAR), xcc, xst, T0())
#define SEAM(k) do { if ((k) + 1 < hi) GBAR(); } while (0)
#define PHASE(kind, idx, ...) do { if (IN(idx)) { const int nrep_ = ((kind) == p.dup_k) ? p.dup_n : 1; for (int rep_ = 0; rep_ < nrep_; ++rep_) { if (rep_) GBAR(); Params q = p; asm volatile("" : "+s"(q.ws), "+s"(q.out));   __VA_ARGS__ } SEAM(idx); } } while (0)
    PHASE(9, 0, phase_prologue(q, lds, wv););
    PHASE(10, 1, phase_lnmod0(q, wv););
#pragma unroll 1
    for (int l = 0; l < DEPTH; ++l) {
        const int pb = 2 + PH_PER_LAYER * l; const bool last = (l == DEPTH - 1);
        const int mrows = last ? NLAT : NTOK;
        PHASE(0, pb + 0,
            pg8::Gemm g{(const bf16_t*)(q.ws + WS_XN), (const bf16_t*)(q.ws + WS_WIN) + (size_t)l * DIN * D, NTOK, DIN, D, 0}; pg8::StaticOrder S; S.init(NTOK, DIN, G, bid);
            pg8::EpiBf16<0> E{(bf16_t*)(q.ws + WS_P), DIN, nullptr, 0, 0, 1.0f};
            pg8::gemm_phase<pg8::EpiBf16<0>, pg8::StaticOrder, true, true>(gl, g, S, E, wv););
        PHASE(1, pb + 1, phase_mix1(q, l, lds, wv, rep_ + 1 < nrep_ ? MIX1_REP_MODE : 3););
        PHASE(2, pb + 2,
            phase_carry(q, wv);
            const int nitem = last ? 256 : 264;
            pg8::Gemm g{(const bf16_t*)(q.ws + WS_T), (const bf16_t*)(q.ws + WS_GT), 256, nitem * 256, 256, 0}; pg8::StaticOrder S; S.init(256, nitem * 256, G, bid);
            EpiDftB E{(bf16_t*)(q.ws + WS_V)};
            pg8::gemm_phase<EpiDftB, pg8::StaticOrder, true, true>(gl, g, S, E, wv););
        PHASE(3, pb + 3, phase_mix3(q, l, lds, wv, rep_ + 1 < nrep_ ? MIX3_REP_MODE : 15););
        PHASE(4, pb + 4,
            pg8::Gemm g{(const bf16_t*)(q.ws + WS_Y), (const bf16_t*)(q.ws + WS_WOUT) + (size_t)l * D * D, mrows, D, D, 0}; pg8::StaticOrder S; S.init(mrows, D, G, bid);
            pg8::EpiBf16<0> E{(bf16_t*)(q.ws + WS_XN), D, nullptr, 0, 0, 1.0f};
            pg8::gemm_phase<pg8::EpiBf16<0>, pg8::StaticOrder, true, true>(gl, g, S, E, wv););
        PHASE(5, pb + 5, const float* sml = (const float*)(q.ws + WS_SM) + (size_t)l * SM_PER_LAYER; phase_ln(q, mrows, sml + SM_LN1G, sml + SM_LN1B, l, 2, l, 3, 4, wv, rep_ + 1 < nrep_ ? 1 : 0););
        PHASE(6, pb + 6,
            pg8::Gemm g{(const bf16_t*)(q.ws + WS_XN), (const bf16_t*)(q.ws + WS_WUP) + (size_t)l * 2 * DFF * D, mrows, 2 * DFF, D, 0}; pg8::StaticOrder S; S.init(mrows, 2 * DFF, G, bid);
            EpiSwiglu E{(bf16_t*)(q.ws + WS_H)};
            pg8::gemm_phase<EpiSwiglu, pg8::StaticOrder, true, true>(gl, g, S, E, wv););
        PHASE(7, pb + 7,
            pg8::Gemm g{(const bf16_t*)(q.ws + WS_H), (const bf16_t*)(q.ws + WS_WDN) + (size_t)l * D * DFF, mrows, D, DFF, 0}; pg8::StaticOrder S; S.init(mrows, D, G, bid);
            pg8::EpiBf16<0> E{(bf16_t*)(q.ws + WS_XN), D, nullptr, 0, 0, 1.0f};
            pg8::gemm_phase<pg8::EpiBf16<0>, pg8::StaticOrder, true, true>(gl, g, S, E, wv););
        PHASE(8, pb + 8, const float* sml = (const float*)(q.ws + WS_SM) + (size_t)l * SM_PER_LAYER; phase_ln(q, mrows, sml + SM_LN2G, sml + SM_LN2B, l, 5, last ? -1 : l + 1, 0, 1, wv, rep_ + 1 < nrep_ ? 1 : 0););
    }
#undef PHASE
#ifdef EXTRA_SYNCS
    for (int i = 0; i < EXTRA_SYNCS; ++i) GBAR();
#endif
#undef IN
#undef SEAM
#undef GBAR
#undef T0
}

}

extern "C" void kernel_launch(void* const* d_in, const int* in_sizes, int n_in, void* d_out, int out_size, void* d_ws, size_t ws_size, hipStream_t stream) {
    unsigned char* ws = (unsigned char*)d_ws;
    static int grid = 0;
    if (grid == 0) {
        if (n_in != 25 || in_sizes[0] != NLAT * D || out_size != NLAT * D || ws_size < WS_END) {
            fprintf(stderr, "kernel_launch: built for 25 inputs, x/out of %d floats and >= %zu bytes of workspace; got n_in %d, in0 %d, out %d, ws %zu; nothing launched\n", NLAT * D, (size_t)WS_END, n_in, n_in > 0 ? in_sizes[0] : -1, out_size, ws_size);
            grid = -1; return; }
        int dev = 0, cus = 0, per_cu = 0;
        if (hipGetDevice(&dev) != hipSuccess || hipDeviceGetAttribute(&cus, hipDeviceAttributeMultiprocessorCount, dev) != hipSuccess) { fprintf(stderr, "kernel_launch: device query failed\n"); grid = -1; return; }
        if (hipFuncSetAttribute((const void*)mega, hipFuncAttributeMaxDynamicSharedMemorySize, LDS_BYTES) != hipSuccess) fprintf(stderr, "kernel_launch: hipFuncSetAttribute failed\n");
        if (hipOccupancyMaxActiveBlocksPerMultiprocessor(&per_cu, (const void*)mega, NTHR, LDS_BYTES) != hipSuccess || per_cu < 1) { fprintf(stderr, "kernel_launch: occupancy query reports %d workgroups per CU\n", per_cu); per_cu = 1; }
        (void)hipGetLastError();
        grid = cus;
    }
    if (grid < 0) return;
    Params base{};
    for (int i = 0; i < 25; ++i) base.in[i] = (const float*)d_in[i];
    base.out = (float*)d_out; base.ws = ws;
#ifdef DUP_K
    base.dup_k = DUP_K; base.dup_n = DUP_N;
#else
    base.dup_k = -1; base.dup_n = 1;
#endif
    base.ph_lo = 0; base.ph_hi = N_PHASES;
    { const int ngw = grid * NWAVE, items = NCHUNK * 16; base.sc_rounds = items / ngw; base.sc_nextra = items - base.sc_rounds * ngw; int sh = 0; if (base.sc_nextra > 0) while ((base.sc_nextra << (sh + 1)) <= ngw) ++sh; base.sc_esh = sh; base.pad = 0; }
    if (hipMemsetAsync(ws + WS_BAR, 0, (size_t)XCD_BAR_WORDS * 4, stream) != hipSuccess) fprintf(stderr, "kernel_launch: memset of the barrier words failed\n");
    void* args[] = {&base};
    const hipError_t e = hipLaunchCooperativeKernel((const void*)mega, dim3(grid), dim3(NTHR), args, LDS_BYTES, stream);
    if (e != hipSuccess) fprintf(stderr, "kernel_launch: cooperative launch failed: %s (grid %d)\n", hipGetErrorString(e), grid);
}
```

```cpp
#include <hip/hip_runtime.h>
#include <hip/hip_cooperative_groups.h>
#ifndef MIX3_REP_MODE
#define MIX3_REP_MODE 15
#endif
#ifndef MIX1_REP_MODE
#define MIX1_REP_MODE 3
#endif
#include <cstdint>
#include <cstdio>
#include <cmath>

namespace cg = cooperative_groups;
namespace pg8 {
#define PG8_LAS __attribute__((address_space(3)))
typedef unsigned short bf16_t;
typedef short bf16x8 __attribute__((ext_vector_type(8)));
typedef float f32x4 __attribute__((ext_vector_type(4)));
typedef unsigned u32x4 __attribute__((ext_vector_type(4)));
constexpr int BM = 256, BK = 64, HALF = 128, HTB = HALF * BK * 2  , STAGE_BYTES = 8 * HTB, NXCD = 8, WGM = 8;

__host__ __device__ __forceinline__ int lds_byte(int r, int c) { const int st = (r >> 4) * 2 + (c >> 5), rr = r & 15, cc = c & 31, ob = rr * 64 + cc * 2; return st * 1024 + (ob ^ (((ob >> 9) & 1) << 5)); }
__host__ __device__ __forceinline__ void stage_rc(int b, int& R, int& C) { const int st = b / 1024, sb = b % 1024, swz = sb ^ (((sb >> 9) & 1) << 5); R = (st >> 1) * 16 + swz / 64; C = (st & 1) * 32 + (swz % 64) / 2; }
__host__ __device__ __forceinline__ int perm32(int rho) { const int n = rho >> 4, i = rho & 15; return 8 * (i >> 2) + 4 * n + (i & 3); }

struct Unit { int pm, pn; };
struct Gemm { const bf16_t* A; const bf16_t* Bt; int M, N, K, pad; };

struct StaticOrder {
    int nM, nN, nwg, G, c;
    __host__ __device__ void init(int M, int N, int G_, int c_) { nM = M / BM; nN = N / BM; nwg = nM * nN; G = G_; c = c_; }
    __host__ __device__ bool next(int i, Unit& u) const {
        const long L = (long)i * G + c; if (L >= nwg) return false;
        int wgid = (int)L; { const int q = nwg / NXCD, r = nwg % NXCD, xcd = wgid % NXCD, off = wgid / NXCD; wgid = (xcd < r ? xcd * (q + 1) : r * (q + 1) + (xcd - r) * q) + off; }
        const int nig = WGM * nN, gid = wgid / nig, fm = gid * WGM, gsz = (nM - fm) < WGM ? (nM - fm) : WGM;
        u.pm = fm + ((wgid % nig) % gsz); u.pn = (wgid % nig) / gsz; return true;
    }
    __device__ __forceinline__ void a_ready(const Unit&) const {}
    __device__ __forceinline__ void done(const Unit&) const {}
};

__device__ __forceinline__ unsigned cvt_pk_bf16(float lo, float hi) { unsigned r; asm volatile("v_cvt_pk_bf16_f32 %0, %1, %2" : "=v"(r) : "v"(lo), "v"(hi)); return r; }
typedef float f32x2 __attribute__((ext_vector_type(2)));
__device__ __forceinline__ f32x2 gelu_pk(f32x2 v) {
    const f32x2 av = __builtin_elementwise_abs(v), d = av * 0.2316418882f + 1.0f;
    f32x2 t; t.x = __builtin_amdgcn_rcpf(d.x); t.y = __builtin_amdgcn_rcpf(d.y);
    f32x2 q = t * 0.5307027145f + (-0.7265760135f); q = q * t + 0.7107068705f; q = q * t + (-0.142248368f); q = q * t + 0.127414796f; q = q * t;
    const f32x2 s = (v * v) * (-0.72134752044f);
    f32x2 e; e.x = __builtin_amdgcn_exp2f(s.x); e.y = __builtin_amdgcn_exp2f(s.y);
    const f32x2 m = v * (q * e), r = v - m;
    f32x2 o; o.x = v.x < 0.f ? m.x : r.x; o.y = v.y < 0.f ? m.y : r.y; return o;
}

template <int ACT  > struct EpiBf16 {
    static constexpr bool PERM = true, AFTER_DRAIN = false; static_assert(ACT == 0 || ACT == 1, "EpiBf16: ACT is 0 (none) or 1 (gelu_pk)");
    bf16_t* O; int ldc; const float* bias; int split_cols; size_t split_stride; float scale0;
    __device__ __forceinline__ void operator()(const f32x4 (&acc)[2][2][4][2], const Unit& u, int wr, int wc, int fr, int fq) const {
        const int row0 = u.pm * BM + wr * 64 + fr; int colt = u.pn * BM; bf16_t* base = O;
        float sc = 1.f; if (split_cols) { const int t = colt / split_cols; base += (size_t)t * split_stride; colt -= t * split_cols; if (t == 0) sc = scale0; }
        const int col0 = colt + wc * 32 + 8 * fq, bcol0 = u.pn * BM + wc * 32 + 8 * fq;
        f32x4 bv[2][2];
#pragma unroll
        for (int bj = 0; bj < 2; ++bj)
#pragma unroll
            for (int n = 0; n < 2; ++n) bv[bj][n] = bias ? *(const f32x4*)(bias + bcol0 + bj * HALF + 4 * n) : (f32x4){0.f, 0.f, 0.f, 0.f};
#pragma unroll
        for (int ai = 0; ai < 2; ++ai)
#pragma unroll
            for (int m = 0; m < 4; ++m) { bf16_t* rowp = base + (size_t)(row0 + ai * HALF + m * 16) * ldc + col0;
#pragma unroll
                for (int bj = 0; bj < 2; ++bj) { f32x4 v0 = acc[ai][bj][m][0] + bv[bj][0], v1 = acc[ai][bj][m][1] + bv[bj][1];
                    if (ACT == 1) { f32x2 a = gelu_pk((f32x2){v0[0], v0[1]}), b = gelu_pk((f32x2){v0[2], v0[3]}), c = gelu_pk((f32x2){v1[0], v1[1]}), d = gelu_pk((f32x2){v1[2], v1[3]});
                        v0 = (f32x4){a.x, a.y, b.x, b.y}; v1 = (f32x4){c.x, c.y, d.x, d.y}; }
                    v0 = v0 * sc; v1 = v1 * sc; u32x4 w; w.x = cvt_pk_bf16(v0[0], v0[1]); w.y = cvt_pk_bf16(v0[2], v0[3]); w.z = cvt_pk_bf16(v1[0], v1[1]); w.w = cvt_pk_bf16(v1[2], v1[3]);
                    *(u32x4*)(rowp + bj * HALF) = w; } }
    }
};

struct EpiF32 {
    static constexpr bool PERM = false, AFTER_DRAIN = false;
    float* C; const float* bias; int ldc, pad;
    __device__ __forceinline__ void operator()(const f32x4 (&acc)[2][2][4][2], const Unit& u, int wr, int wc, int fr, int fq) const {
        const int row0 = u.pm * BM + wr * 64 + fr, col0 = u.pn * BM + wc * 32 + 4 * fq;
        f32x4 bv[2][2];
#pragma unroll
        for (int bj = 0; bj < 2; ++bj)
#pragma unroll
            for (int n = 0; n < 2; ++n) bv[bj][n] = bias ? *(const f32x4*)(bias + col0 + bj * HALF + n * 16) : (f32x4){0.f, 0.f, 0.f, 0.f};
#pragma unroll
        for (int ai = 0; ai < 2; ++ai)
#pragma unroll
            for (int m = 0; m < 4; ++m) { float* rowp = C + (size_t)(row0 + ai * HALF + m * 16) * ldc + col0;
#pragma unroll
                for (int bj = 0; bj < 2; ++bj)
#pragma unroll
                    for (int n = 0; n < 2; ++n) *(f32x4*)(rowp + bj * HALF + n * 16) = acc[ai][bj][m][n] + bv[bj][n]; }
    }
};

template <class Epi, class Sched, bool ALIGN_EPI = false, bool SP2 = false>
__device__ __forceinline__ void gemm_phase(PG8_LAS unsigned char* lds, const Gemm g, const Sched& S, const Epi& E, int wv_) {
    int ln_; asm volatile("v_mbcnt_lo_u32_b32 %0, -1, 0\n\tv_mbcnt_hi_u32_b32 %0, -1, %0" : "=v"(ln_)); const int tid_ = (wv_ << 6) | ln_;
    const int tid = tid_, wid = __builtin_amdgcn_readfirstlane(tid >> 6), lane = tid & 63, wr = wid >> 2, wc = wid & 3, fr = lane & 15, fq = lane >> 4;
    const int K = g.K, nt = K / BK;
    unsigned voffA[2], voffB[2];
#pragma unroll
    for (int i = 0; i < 2; ++i) { int R, C; stage_rc(tid * 16 + i * 8192, R, C); const int Rb = Epi::PERM ? ((R & ~31) + perm32(R & 31)) : R;
        voffA[i] = (unsigned)(R * K + C) * 2u; voffB[i] = (unsigned)(Rb * K + C) * 2u; }
    const size_t kstep = (size_t)(BK * 2);
    const size_t hstep = (size_t)HALF * K * 2;
    const size_t tstep = 2 * hstep;
    const unsigned ldsw = (unsigned)wid * 1024u;
    const int aoff = lds_byte(wr * 64 + fr, fq * 8), boff = lds_byte(wc * 32 + fr, fq * 8);
#define PG8_SA(b, h) (((b) * 2 + (h)) * HTB)
#define PG8_SB(b, h) ((4 + (b) * 2 + (h)) * HTB)
#define PG8_STAGE(bufoff, gbase, voff) do { _Pragma("unroll") for (int _i = 0; _i < 2; ++_i) \
        __builtin_amdgcn_global_load_lds((const unsigned*)((const char*)(gbase) + (voff)[_i]), (PG8_LAS unsigned*)(lds + (bufoff) + ldsw + _i * 8192), 16, 0, 0); } while (0)
#define PG8_LDA(dst, b, h) do { _Pragma("unroll") for (int m = 0; m < 4; ++m) _Pragma("unroll") for (int k = 0; k < 2; ++k) dst[m][k] = *(const PG8_LAS bf16x8*)(lds + PG8_SA(b, h) + aoff + m * 2048 + k * 1024); } while (0)
#define PG8_LDB(dst, b, h) do { _Pragma("unroll") for (int n = 0; n < 2; ++n) _Pragma("unroll") for (int k = 0; k < 2; ++k) dst[n][k] = *(const PG8_LAS bf16x8*)(lds + PG8_SB(b, h) + boff + n * 2048 + k * 1024); } while (0)
#define PG8_MMA(ai, bj, At, Bt) do { __builtin_amdgcn_s_setprio(1); _Pragma("unroll") for (int m = 0; m < 4; ++m) _Pragma("unroll") for (int n = 0; n < 2; ++n) _Pragma("unroll") for (int k = 0; k < 2; ++k) \
        acc[ai][bj][m][n] = __builtin_amdgcn_mfma_f32_16x16x32_bf16(Bt[n][k], At[m][k], acc[ai][bj][m][n], 0, 0, 0); __builtin_amdgcn_s_setprio(0); } while (0)
#define PG8_WAIT_V(n) asm volatile("s_waitcnt vmcnt(" #n ")" ::: "memory")
#define PG8_WAIT_L(n) asm volatile("s_waitcnt lgkmcnt(" #n ")" ::: "memory")
#define PG8_BAR __builtin_amdgcn_s_barrier()
#define PG8_SCHED __builtin_amdgcn_sched_barrier(0)
    Unit cur, nxt; int ui = 0;
    if (!S.next(0, cur)) return;
    f32x4 acc[2][2][4][2];
#pragma unroll
    for (int a = 0; a < 2; ++a)
#pragma unroll
        for (int b = 0; b < 2; ++b)
#pragma unroll
            for (int m = 0; m < 4; ++m)
#pragma unroll
                for (int n = 0; n < 2; ++n) acc[a][b][m][n] = (f32x4){0.f, 0.f, 0.f, 0.f};
    bf16x8 At[4][2], B0[2][2], B1[2][2];
    const char* cA = (const char*)g.A + (size_t)cur.pm * tstep; const char* cB = (const char*)g.Bt + (size_t)cur.pn * tstep;
    S.a_ready(cur);
    if constexpr (SP2) {
        PG8_STAGE(PG8_SB(0, 0), cB, voffB); PG8_STAGE(PG8_SB(0, 1), cB + hstep, voffB); PG8_STAGE(PG8_SA(0, 0), cA, voffA); PG8_STAGE(PG8_SA(0, 1), cA + hstep, voffA);
        if (wr == 1) PG8_BAR;
        PG8_WAIT_V(2); PG8_BAR;
        PG8_STAGE(PG8_SB(1, 0), cB + kstep, voffB); PG8_STAGE(PG8_SA(1, 0), cA + kstep, voffA); PG8_STAGE(PG8_SB(1, 1), cB + hstep + kstep, voffB);
        PG8_WAIT_V(6); PG8_BAR;
    } else {
        PG8_STAGE(PG8_SB(0, 0), cB, voffB); PG8_STAGE(PG8_SA(0, 0), cA, voffA); PG8_STAGE(PG8_SB(0, 1), cB + hstep, voffB); PG8_STAGE(PG8_SA(0, 1), cA + hstep, voffA);
        if (wr == 1) PG8_BAR;
        PG8_WAIT_V(4); PG8_BAR;
        PG8_STAGE(PG8_SB(1, 0), cB + kstep, voffB); PG8_STAGE(PG8_SA(1, 0), cA + kstep, voffA); PG8_STAGE(PG8_SB(1, 1), cB + hstep + kstep, voffB);
        PG8_WAIT_V(6); PG8_BAR;
    }
    for (;;) {
        const bool has_next = S.next(ui + 1, nxt);
        const char* nA = has_next ? (const char*)g.A + (size_t)nxt.pm * tstep : cA; const char* nB = has_next ? (const char*)g.Bt + (size_t)nxt.pn * tstep : cB;
        for (int t = 0; t < nt; t += 2) {
            const bool last = (t == nt - 2);
            const char* a1 = cA + (size_t)(t + 1) * kstep;
            const char* a2 = last ? nA : cA + (size_t)(t + 2) * kstep; const char* b2 = last ? nB : cB + (size_t)(t + 2) * kstep;
            const char* a3 = a2 + kstep; const char* b3 = b2 + kstep;
            if (last && has_next) S.a_ready(nxt);
            if constexpr (SP2) {
            PG8_LDB(B0, 0, 0); PG8_LDB(B1, 0, 1); PG8_SCHED; PG8_LDA(At, 0, 0); PG8_STAGE(PG8_SA(1, 1), a1 + hstep, voffA);
            PG8_WAIT_V(8); PG8_WAIT_L(0); PG8_BAR; PG8_MMA(0, 0, At, B0); PG8_MMA(0, 1, At, B1); PG8_BAR; PG8_SCHED;
            PG8_LDA(At, 0, 1); PG8_STAGE(PG8_SB(0, 0), b2, voffB); PG8_STAGE(PG8_SB(0, 1), b2 + hstep, voffB); PG8_STAGE(PG8_SA(0, 0), a2, voffA);
            PG8_WAIT_V(8); PG8_WAIT_L(0); PG8_BAR; PG8_MMA(1, 0, At, B0); PG8_MMA(1, 1, At, B1); PG8_BAR; PG8_SCHED;
            PG8_LDB(B0, 1, 0); PG8_LDB(B1, 1, 1); PG8_SCHED; PG8_LDA(At, 1, 0); PG8_STAGE(PG8_SA(0, 1), a2 + hstep, voffA);
            PG8_WAIT_V(8); PG8_WAIT_L(0); PG8_BAR; PG8_MMA(0, 0, At, B0); PG8_MMA(0, 1, At, B1); PG8_BAR; PG8_SCHED;
            PG8_LDA(At, 1, 1); PG8_STAGE(PG8_SB(1, 0), b3, voffB); PG8_STAGE(PG8_SB(1, 1), b3 + hstep, voffB); PG8_STAGE(PG8_SA(1, 0), a3, voffA);
            PG8_WAIT_V(8); PG8_WAIT_L(0); PG8_BAR; PG8_MMA(1, 0, At, B0); PG8_MMA(1, 1, At, B1); PG8_BAR; PG8_SCHED;
            } else {
            PG8_LDB(B0, 0, 0); PG8_SCHED; PG8_LDA(At, 0, 0); PG8_STAGE(PG8_SA(1, 1), a1 + hstep, voffA);
            PG8_WAIT_L(8); PG8_BAR; PG8_WAIT_L(0); PG8_MMA(0, 0, At, B0); PG8_BAR; PG8_SCHED;
            PG8_LDB(B1, 0, 1); PG8_STAGE(PG8_SB(0, 0), b2, voffB);
            PG8_BAR; PG8_WAIT_L(0); PG8_MMA(0, 1, At, B1); PG8_BAR;
            PG8_LDA(At, 0, 1); PG8_STAGE(PG8_SA(0, 0), a2, voffA);
            PG8_BAR; PG8_WAIT_L(0); PG8_MMA(1, 0, At, B0); PG8_BAR; PG8_SCHED;
            PG8_STAGE(PG8_SB(0, 1), b2 + hstep, voffB);
            PG8_WAIT_V(6); PG8_BAR; PG8_MMA(1, 1, At, B1); PG8_BAR;
            PG8_LDB(B0, 1, 0); PG8_SCHED; PG8_LDA(At, 1, 0); PG8_STAGE(PG8_SA(0, 1), a2 + hstep, voffA);
            PG8_WAIT_L(8); PG8_BAR; PG8_WAIT_L(0); PG8_MMA(0, 0, At, B0); PG8_BAR; PG8_SCHED;
            PG8_LDB(B1, 1, 1); PG8_STAGE(PG8_SB(1, 0), b3, voffB);
            PG8_BAR; PG8_WAIT_L(0); PG8_MMA(0, 1, At, B1); PG8_BAR;
            PG8_LDA(At, 1, 1); PG8_STAGE(PG8_SA(1, 0), a3, voffA);
            PG8_BAR; PG8_WAIT_L(0); PG8_MMA(1, 0, At, B0); PG8_BAR; PG8_SCHED;
            PG8_STAGE(PG8_SB(1, 1), b3 + hstep, voffB);
            PG8_WAIT_V(6); PG8_BAR; PG8_MMA(1, 1, At, B1); PG8_BAR;
            }
        }
        if constexpr (ALIGN_EPI) { if (wr == 0) PG8_BAR; }
        if constexpr (!Epi::AFTER_DRAIN) { E(acc, cur, wr, wc, fr, fq); S.done(cur); }
        if (!has_next) break;
#pragma unroll
        for (int a = 0; a < 2; ++a)
#pragma unroll
            for (int b = 0; b < 2; ++b)
#pragma unroll
                for (int m = 0; m < 4; ++m)
#pragma unroll
                    for (int n = 0; n < 2; ++n) acc[a][b][m][n] = (f32x4){0.f, 0.f, 0.f, 0.f};
        cur = nxt; cA = nA; cB = nB; ++ui;
        if constexpr (ALIGN_EPI) { if (wr == 1) PG8_BAR; }
    }
    PG8_WAIT_V(0);
    if constexpr (!ALIGN_EPI) { if (wr == 0) PG8_BAR; }
    PG8_BAR;
    if constexpr (Epi::AFTER_DRAIN) { E.fused(acc, cur, wr, wc, fr, fq, lds, wid, lane); S.done(cur); }
#undef PG8_SA
#undef PG8_SB
#undef PG8_STAGE
#undef PG8_LDA
#undef PG8_LDB
#undef PG8_MMA
#undef PG8_WAIT_V
#undef PG8_WAIT_L
#undef PG8_BAR
#undef PG8_SCHED
}
}

namespace {
constexpr int D = 1024, NB = 4, SEQ = 8192, CTX = 256, DEPTH = 2;
constexpr int DA = 512, DB = 256, DC = 256, DIN = 1792, HD = 64, CHUNK = 128, DFF = 2816, NMOD = 6;
constexpr int NLAT = NB * SEQ, NCTX = NB * CTX;
constexpr float LN_EPS = 1e-6f;
constexpr float ALPHA = 1.41421356237309515f;
constexpr float PI_F = 3.14159265358979323846f;

typedef unsigned short bf16_t;
__device__ __forceinline__ bf16_t f2bf(float f) { unsigned r; asm("v_cvt_pk_bf16_f32 %0, %1, %1" : "=v"(r) : "v"(f)); return (bf16_t)(r & 0xffffu); }
__device__ __forceinline__ float bf2f(bf16_t h) { return __builtin_bit_cast(float, (unsigned)h << 16); }
__device__ __forceinline__ void st_val(float* p, float v) { *p = v; }
__device__ __forceinline__ void st_val(bf16_t* p, float v) { *p = f2bf(v); }
__device__ __forceinline__ float gelu_f(float v) { return 0.5f * v * (1.0f + erff(v * 0.70710678118654752f)); }
__device__ __forceinline__ float sigmoid_f(float v) { return 1.0f / (1.0f + expf(-v)); }
__device__ __forceinline__ float silu_f(float v) { return v / (1.0f + expf(-v)); }

__device__ __forceinline__ float block_sum256(float v, float* sh) {
#pragma unroll
    for (int o = 32; o > 0; o >>= 1) v += __shfl_xor(v, o);
    __syncthreads();
    if ((threadIdx.x & 63) == 0) sh[threadIdx.x >> 6] = v;
    __syncthreads();
    return (sh[0] + sh[1]) + (sh[2] + sh[3]);
}

constexpr int NTOK = NLAT + NCTX, NCHUNK = NTOK / CHUNK;
constexpr size_t al256(size_t x) { return (x + 255) & ~(size_t)255; }
constexpr size_t WS_MOD = 0;
constexpr size_t WS_TAB = WS_MOD + al256((size_t)DEPTH * 5 * NMOD * D * 4);
constexpr size_t WS_XCTX = WS_TAB + al256((size_t)2 * 8192 * 4);
constexpr size_t WS_HC = WS_XCTX + al256((size_t)NCTX * D * 4);
constexpr size_t WS_AGG = WS_HC + al256((size_t)NB * 2 * DA * 4);
constexpr size_t WS_T = WS_AGG + al256((size_t)NCHUNK * 2 * 2 * DA * 4);
constexpr size_t WS_MM = WS_T + al256((size_t)256 * 256 * 2);
constexpr int SM_CONVW = 0, SM_CONVB = 2048, SM_BA = 2560, SM_BX = 3584, SM_SP8 = 4608, SM_SGB = 5632, SM_GMIX = 6144, SM_LN1G = 7168, SM_LN1B = 8192, SM_LN2G = 9216, SM_LN2B = 10240, SM_PER_LAYER = 11264;
constexpr size_t WS_SM = WS_MM + al256((size_t)DEPTH * 4 * 128 * 64 * 4);
constexpr size_t WS_SGW = WS_SM + al256((size_t)DEPTH * SM_PER_LAYER * 4);
constexpr size_t WS_SGWB = WS_SGW + al256((size_t)DEPTH * 4 * CHUNK * CHUNK * 4);
constexpr size_t WS_MMT = WS_SGWB + al256((size_t)DEPTH * 4 * CHUNK * CHUNK * 2);
constexpr size_t WS_WG = WS_MMT + al256((size_t)DEPTH * 4 * 64 * 128 * 2);
constexpr size_t WS_WIN = WS_WG + al256((size_t)2 * DEPTH * 2 * 8 * 64 * 64 * 2);
constexpr size_t WS_WOUT = WS_WIN + al256((size_t)DEPTH * DIN * D * 2);
constexpr size_t WS_WUP = WS_WOUT + al256((size_t)DEPTH * D * D * 2);
constexpr size_t WS_WDN = WS_WUP + al256((size_t)DEPTH * 2 * DFF * D * 2);
constexpr size_t WS_XN = WS_WDN + al256((size_t)DEPTH * D * DFF * 2);
constexpr size_t WS_GT = WS_XN;
constexpr size_t WS_V = WS_XN + (size_t)NTOK * 512 * 2;
constexpr size_t WS_P = WS_XN + al256((size_t)NTOK * D * 2);
constexpr size_t WS_Y = WS_P + (size_t)NTOK * DIN * 2;
constexpr size_t WS_H = WS_P;
constexpr size_t WS_HF = WS_Y + al256((size_t)NTOK * D * 2);
constexpr size_t WS_HB = WS_HF + al256((size_t)NTOK * DA * 2);
constexpr size_t WS_AF = WS_HB + al256((size_t)NTOK * DA * 2);
constexpr size_t WS_AB = WS_AF + al256((size_t)NTOK * DA * 2);
constexpr size_t WS_TA = WS_AB + al256((size_t)NTOK * DA * 2);
constexpr size_t WS_CARRY = WS_TA + al256((size_t)128 * 64 * 2);
constexpr size_t WS_BAR = WS_CARRY + al256((size_t)NCHUNK * 2 * DA * 4);
constexpr size_t WS_END = WS_BAR + al256((size_t)3456 * 4);
static_assert((size_t)NTOK * DFF * 2 == (size_t)NTOK * DIN * 2 + (size_t)NTOK * D * 2, "H overlays exactly P + Y");
constexpr int LDS_BYTES = 147456;
constexpr int NTHR = 512, NWAVE = 8;

struct Params { const float* in[25]; float* out; unsigned char* ws; int ph_lo, ph_hi, dup_k, dup_n; int sc_rounds, sc_nextra, sc_esh, pad; };
enum { I_X = 0, I_C, I_CTX, I_CCTX, I_WMOD, I_BMOD, I_WIN, I_CONVW, I_CONVB, I_WA, I_BA, I_WX, I_BX, I_LAM, I_SGW, I_SGB, I_FW, I_GMIX, I_WOUT, I_LN1G, I_LN1B, I_WUP, I_WDN, I_LN2G, I_LN2B };

typedef float f32x4 __attribute__((ext_vector_type(4)));
typedef unsigned u32x2 __attribute__((ext_vector_type(2)));
typedef unsigned u32x4 __attribute__((ext_vector_type(4)));
__device__ __forceinline__ int opaque_lane() { int l; asm volatile("v_mbcnt_lo_u32_b32 %0, -1, 0\n\tv_mbcnt_hi_u32_b32 %0, -1, %0" : "=v"(l)); return l; }
__device__ __forceinline__ int opaque_tid(int wv) { return (wv << 6) | opaque_lane(); }
__device__ __forceinline__ unsigned pk2(float lo, float hi) { unsigned r; asm("v_cvt_pk_bf16_f32 %0, %1, %2" : "=v"(r) : "v"(lo), "v"(hi)); return r; }
__device__ __forceinline__ float wave_sum(float v) {
#pragma unroll
    for (int o = 1; o < 64; o <<= 1) v += __shfl_xor(v, o);
    return v;
}
__device__ __forceinline__ float* xrow_ptr(const Params& p, int r) { return r < NLAT ? p.out + (size_t)r * D : (float*)(p.ws + WS_XCTX) + (size_t)(r - NLAT) * D; }
__device__ __forceinline__ int mod_row(int r) { return r < NLAT ? r / SEQ : 4; }
__device__ __forceinline__ const float* mod_ptr(const Params& p, int l, int r, int idx) { return (const float*)(p.ws + WS_MOD) + ((size_t)(l * 5 + mod_row(r)) * NMOD + idx) * D; }

struct EpiResid {
    static constexpr bool PERM = false, AFTER_DRAIN = false;
    float* xlat; float* xctx; const float* modl; int gate_idx; int dry;
    __device__ __forceinline__ void operator()(const pg8::f32x4 (&acc)[2][2][4][2], const pg8::Unit& u, int wr, int wc, int fr, int fq) const {
        const int rt = u.pm * 256;
        float* xb = rt < NLAT ? xlat + (size_t)rt * D : xctx + (size_t)(rt - NLAT) * D;
        const float* gp = modl + ((size_t)(rt < NLAT ? rt / SEQ : 4) * NMOD + gate_idx) * D;
        const int row0 = wr * 64 + fr, col0 = u.pn * 256 + wc * 32 + 4 * fq;
        pg8::f32x4 gv[2][2];
#pragma unroll
        for (int bj = 0; bj < 2; ++bj)
#pragma unroll
            for (int n = 0; n < 2; ++n) gv[bj][n] = *(const pg8::f32x4*)(gp + col0 + bj * 128 + n * 16);
#pragma unroll
        for (int ai = 0; ai < 2; ++ai)
#pragma unroll
            for (int m = 0; m < 4; ++m) { float* rowp = xb + (size_t)(row0 + ai * 128 + m * 16) * D + col0;
#pragma unroll
                for (int bj = 0; bj < 2; ++bj)
#pragma unroll
                    for (int n = 0; n < 2; ++n) { const pg8::f32x4 xv = *(const pg8::f32x4*)(rowp + bj * 128 + n * 16); const pg8::f32x4 zv = xv * ALPHA + gv[bj][n] * acc[ai][bj][m][n]; *(pg8::f32x4*)(rowp + bj * 128 + n * 16) = dry ? xv : zv; }
                asm volatile("" ::: "memory"); }
    }
};
__device__ __forceinline__ float silu_fast(float v) { return v * __builtin_amdgcn_rcpf(1.0f + __builtin_amdgcn_exp2f(-1.44269504089f * v)); }
struct EpiSwiglu {
    static constexpr bool PERM = true, AFTER_DRAIN = false;
    bf16_t* H;
    __device__ __forceinline__ void operator()(const pg8::f32x4 (&acc)[2][2][4][2], const pg8::Unit& u, int wr, int wc, int fr, int fq) const {
        const int row0 = u.pm * 256 + wr * 64 + fr, col0 = u.pn * 128 + wc * 32 + 8 * fq;
#pragma unroll
        for (int ai = 0; ai < 2; ++ai)
#pragma unroll
            for (int m = 0; m < 4; ++m) { bf16_t* rowp = H + (size_t)(row0 + ai * 128 + m * 16) * DFF + col0;
                const pg8::f32x4 g0 = acc[ai][0][m][0], g1 = acc[ai][0][m][1], u0 = acc[ai][1][m][0], u1 = acc[ai][1][m][1];
                pg8::u32x4 w;
                w.x = pk2(silu_fast(g0[0]) * u0[0], silu_fast(g0[1]) * u0[1]); w.y = pk2(silu_fast(g0[2]) * u0[2], silu_fast(g0[3]) * u0[3]);
                w.z = pk2(silu_fast(g1[0]) * u1[0], silu_fast(g1[1]) * u1[1]); w.w = pk2(silu_fast(g1[2]) * u1[2], silu_fast(g1[3]) * u1[3]);
                *(pg8::u32x4*)rowp = w; }
    }
};

__device__ __forceinline__ void transpose_item(const float* W, int K, int N, bf16_t* WT, int src_n0, int dst_n0, int k0, float* scr, int lane) {
#pragma unroll 16
    for (int i = 0; i < 32; ++i) { const int kk = 2 * i + (lane >> 5); scr[kk * 33 + (lane & 31)] = W[(size_t)(k0 + kk) * N + src_n0 + (lane & 31)]; }
    __builtin_amdgcn_s_waitcnt(0); __builtin_amdgcn_wave_barrier();
    const int c = lane & 7;
#pragma unroll
    for (int j = 0; j < 4; ++j) { const int n = (lane >> 3) + 8 * j; const float* sp = scr + (8 * c) * 33 + n;
        u32x4 o; o.x = pk2(sp[0 * 33], sp[1 * 33]); o.y = pk2(sp[2 * 33], sp[3 * 33]); o.z = pk2(sp[4 * 33], sp[5 * 33]); o.w = pk2(sp[6 * 33], sp[7 * 33]);
        *(u32x4*)(WT + (size_t)(dst_n0 + n) * K + k0 + 8 * c) = o; }
    __builtin_amdgcn_s_waitcnt(0); __builtin_amdgcn_wave_barrier();
}

__device__ __forceinline__ void phase_prologue(const Params& p, unsigned char* lds, int wv) {
    const int tid = opaque_tid(wv), lane = tid & 63, wave = tid >> 6, bid = blockIdx.x, G = gridDim.x;
    const int gtid = bid * NTHR + tid, GT_ = G * NTHR, gw = bid * NWAVE + wave, NGW = G * NWAVE;
    {
        float* sc = (float*)lds; float* red = (float*)(lds + 20480);
        bool have = false;
        for (int it = bid; it < DEPTH * 96; it += G) {
            if (!have) { for (int i = tid; i < 5 * D; i += NTHR) { const int r = i / D, k = i % D; const float v = r < 4 ? p.in[I_C][r * D + k] : p.in[I_CCTX][k]; sc[i] = silu_f(v); } have = true; }
            __syncthreads();
            const int l = it / 96, col = (it % 96) * 64 + lane;
            const float* w = p.in[I_WMOD] + ((size_t)l * D + wave * 128) * NMOD * D + col;
            float a0 = 0.f, a1 = 0.f, a2 = 0.f, a3 = 0.f, a4 = 0.f;
#pragma unroll 8
            for (int k = 0; k < 128; ++k) { const float wv = w[(size_t)k * NMOD * D]; const int kk = wave * 128 + k;
                a0 += sc[kk] * wv; a1 += sc[D + kk] * wv; a2 += sc[2 * D + kk] * wv; a3 += sc[3 * D + kk] * wv; a4 += sc[4 * D + kk] * wv; }
            red[(wave * 5 + 0) * 64 + lane] = a0; red[(wave * 5 + 1) * 64 + lane] = a1; red[(wave * 5 + 2) * 64 + lane] = a2; red[(wave * 5 + 3) * 64 + lane] = a3; red[(wave * 5 + 4) * 64 + lane] = a4;
            __syncthreads();
            if (tid < 320) { const int r = tid >> 6; float sum = 0.f;
#pragma unroll
                for (int w2 = 0; w2 < 8; ++w2) sum += red[(w2 * 5 + r) * 64 + lane];
                ((float*)(p.ws + WS_MOD))[((size_t)(l * 5 + r)) * NMOD * D + col] = sum + p.in[I_BMOD][(size_t)l * NMOD * D + col]; }
            __syncthreads();
        }
        __syncthreads();
    }
    {
        float* scr = (float*)(lds + 32768) + wave * (64 * 33);
        constexpr int I_IN = 16 * 56, I_OUT = 16 * 32, I_UP = 16 * 176, I_DN = 44 * 32, I_L = I_IN + I_OUT + I_UP + I_DN;
        for (int it = gw; it < DEPTH * I_L; it += NGW) {
            const int l = it / I_L; int r = it % I_L;
            if (r < I_IN) { const int kb = r / 56, nb = r % 56; transpose_item(p.in[I_WIN] + (size_t)l * D * DIN, D, DIN, (bf16_t*)(p.ws + WS_WIN) + (size_t)l * DIN * D, nb * 32, nb * 32, kb * 64, scr, lane); continue; }
            r -= I_IN;
            if (r < I_OUT) { const int kb = r / 32, nb = r % 32; transpose_item(p.in[I_WOUT] + (size_t)l * D * D, D, D, (bf16_t*)(p.ws + WS_WOUT) + (size_t)l * D * D, nb * 32, nb * 32, kb * 64, scr, lane); continue; }
            r -= I_OUT;
            if (r < I_UP) { const int kb = r / 176, nb = r % 176; const int sn = nb * 32; const int isup = sn >= DFF ? 1 : 0; const int sj = sn - isup * DFF; const int dn = (sj / 128) * 256 + isup * 128 + (sj % 128);
                transpose_item(p.in[I_WUP] + (size_t)l * D * 2 * DFF, D, 2 * DFF, (bf16_t*)(p.ws + WS_WUP) + (size_t)l * 2 * DFF * D, sn, dn, kb * 64, scr, lane); continue; }
            r -= I_UP;
            { const int kb = r / 32, nb = r % 32; transpose_item(p.in[I_WDN] + (size_t)l * DFF * D, DFF, D, (bf16_t*)(p.ws + WS_WDN) + (size_t)l * D * DFF, nb * 32, nb * 32, kb * 64, scr, lane); }
        }
    }
    float* tab = (float*)(p.ws + WS_TAB);
    for (int j = gtid; j < 8192; j += GT_) { tab[j] = cospif((float)j / 4096.0f); tab[8192 + j] = sinpif((float)j / 4096.0f); }
    { bf16_t* TA = (bf16_t*)(p.ws + WS_TA);
      for (int i = gtid; i < 128 * 64; i += GT_) { const int l1 = i & 63, m = i >> 6, k1 = m >> 1, comp = m & 1; const float a = (float)((k1 * l1) & 63) / 32.0f; TA[i] = f2bf(comp ? -sinpif(a) : cospif(a)); } }
    bf16_t* T = (bf16_t*)(p.ws + WS_T);
    for (int i = gtid; i < 256 * 256; i += GT_) { const int m = i >> 8, kk = i & 255, k2 = m & 127, co = m >> 7, l2 = kk >> 1, ci = kk & 1; const float a = (float)((k2 * l2) & 127) / 64.0f;
        const float cv = cospif(a), sv = sinpif(a); T[i] = f2bf(co == 0 ? (ci == 0 ? cv : sv) : (ci == 0 ? -sv : cv)); }
    { bf16_t* WG = (bf16_t*)(p.ws + WS_WG);
      for (int i = gtid; i < 2 * DEPTH * 2 * 8 * 64 * 64; i += GT_) { const int c = i & 63, e = (i >> 6) & 63, ldh = (i >> 12) & 31, gsel = i >> 17;
          const float* src = (gsel ? p.in[I_WX] : p.in[I_WA]) + ((size_t)ldh * 64 + c) * 64 + e; WG[i] = f2bf(*src); } }
    { float* SM = (float*)(p.ws + WS_SM);
      for (int i = gtid; i < DEPTH * SM_PER_LAYER; i += GT_) { const int l = i / SM_PER_LAYER, o = i % SM_PER_LAYER; float v;
          if (o < SM_CONVB) v = p.in[I_CONVW][l * 2048 + o];
          else if (o < SM_BA) v = p.in[I_CONVB][l * 512 + o - SM_CONVB];
          else if (o < SM_BX) v = p.in[I_BA][l * 1024 + o - SM_BA];
          else if (o < SM_SP8) v = p.in[I_BX][l * 1024 + o - SM_BX];
          else if (o < SM_SGB) v = -8.0f * log1pf(expf(-p.in[I_LAM][l * 1024 + o - SM_SP8]));
          else if (o < SM_GMIX) v = p.in[I_SGB][l * 512 + o - SM_SGB];
          else if (o < SM_LN1G) v = p.in[I_GMIX][l * 1024 + o - SM_GMIX];
          else if (o < SM_LN1B) v = p.in[I_LN1G][l * 1024 + o - SM_LN1G];
          else if (o < SM_LN2G) v = p.in[I_LN1B][l * 1024 + o - SM_LN1B];
          else if (o < SM_LN2B) v = p.in[I_LN2G][l * 1024 + o - SM_LN2G];
          else v = p.in[I_LN2B][l * 1024 + o - SM_LN2B];
          SM[i] = v; }
      bf16_t* SGWB = (bf16_t*)(p.ws + WS_SGWB);
      for (int i = gtid; i < DEPTH * 4 * CHUNK * CHUNK; i += GT_) SGWB[i] = f2bf(p.in[I_SGW][i]);
      bf16_t* MMT = (bf16_t*)(p.ws + WS_MMT);
      for (int i = gtid; i < DEPTH * 4 * 64 * 128; i += GT_) { const int j = i & 127, e = (i >> 7) & 63, lh = i >> 13; const int cc = j >> 1, comp = j & 1;
          const float* wf = p.in[I_FW] + ((size_t)lh * 64) * 64 + e; float sum = 0.f;
          for (int m = 0; m < 64; ++m) { const float a = (float)((cc * m) & 63) / 32.0f; sum += (comp ? sinpif(a) : cospif(a)) * wf[m * 64]; }
          MMT[i] = f2bf(sum); } }
}

__device__ __forceinline__ void ln_stats(f32x4 (&v)[4], float& rstd) {
    float s = 0.f;
#pragma unroll
    for (int j = 0; j < 4; ++j) s += (v[j][0] + v[j][1]) + (v[j][2] + v[j][3]);
    const float mean = wave_sum(s) * (1.0f / D); float q = 0.f;
#pragma unroll
    for (int j = 0; j < 4; ++j) { v[j] = v[j] - mean; q += (v[j][0] * v[j][0] + v[j][1] * v[j][1]) + (v[j][2] * v[j][2] + v[j][3] * v[j][3]); }
    rstd = rsqrtf(wave_sum(q) * (1.0f / D) + LN_EPS);
}
__device__ __forceinline__ void lnmod_store(const Params& p, f32x4 (&v)[4], int l, int r, int shift_idx, int scale_idx, int lane) {
    float rstd; ln_stats(v, rstd);
    const f32x4* sh = (const f32x4*)mod_ptr(p, l, r, shift_idx) + lane; const f32x4* sc = (const f32x4*)mod_ptr(p, l, r, scale_idx) + lane;
    u32x2* o = (u32x2*)((bf16_t*)(p.ws + WS_XN) + (size_t)r * D) + lane;
#pragma unroll
    for (int j = 0; j < 4; ++j) { const f32x4 a = sc[64 * j], b = sh[64 * j]; f32x4 y = v[j] * rstd * (a + 1.0f) + b; u32x2 w; w.x = pk2(y[0], y[1]); w.y = pk2(y[2], y[3]); o[64 * j] = w; }
}
__device__ __forceinline__ void phase_lnmod0(const Params& p, int wv) {
    const int lane = opaque_lane(), gw = blockIdx.x * NWAVE + wv, NGW = gridDim.x * NWAVE;
    for (int t = gw; t < SEQ; t += NGW) {
        f32x4 pe[4];
#pragma unroll
        for (int k = 0; k < 4; ++k) { const float freq = exp2f(-(float)(4 * lane + k) * (13.287712379549449f / 256.0f)) * 0.3183098861837907f; const float ar = (float)(t / 64) * freq, ac = (float)(t % 64) * freq;
            pe[0][k] = sinpif(ar); pe[1][k] = cospif(ar); pe[2][k] = sinpif(ac); pe[3][k] = cospif(ac); }
        f32x4 xa[NB][4];
#pragma unroll
        for (int b = 0; b < NB; ++b) { const f32x4* xr = (const f32x4*)(p.in[I_X] + (size_t)(b * SEQ + t) * D) + lane;
#pragma unroll
            for (int j = 0; j < 4; ++j) xa[b][j] = xr[64 * j]; }
#pragma unroll
        for (int b = 0; b < NB; ++b) { const int r = b * SEQ + t; f32x4* xo = (f32x4*)(p.out + (size_t)r * D) + lane; f32x4 v[4];
#pragma unroll
            for (int j = 0; j < 4; ++j) { v[j] = xa[b][j] + pe[j]; xo[64 * j] = v[j]; }
            lnmod_store(p, v, 0, r, 0, 1, lane); }
    }
    for (int rc = gw; rc < NCTX; rc += NGW) { const int r = NLAT + rc; const f32x4* xr = (const f32x4*)(p.in[I_CTX] + (size_t)rc * D) + lane; f32x4* xo = (f32x4*)(p.ws + WS_XCTX + (size_t)rc * D * 4) + lane; f32x4 v[4];
#pragma unroll
        for (int j = 0; j < 4; ++j) { v[j] = xr[64 * j]; xo[64 * j] = v[j]; }
        lnmod_store(p, v, 0, r, 0, 1, lane); }
}
__device__ __forceinline__ void wave_sum2(float& a, float& b) {
#pragma unroll
    for (int o = 1; o < 64; o <<= 1) { const float ta = __shfl_xor(a, o), tb = __shfl_xor(b, o); a += ta; b += tb; }
}
__device__ __forceinline__ void phase_ln(const Params& p, int nrows, const float* g, const float* b, int l, int gate_idx, int nl, int shift_idx, int scale_idx, int wv, int dry) {
    const int lane = opaque_lane(), gw = blockIdx.x * NWAVE + wv, NGW = gridDim.x * NWAVE;
    const bf16_t* T = (const bf16_t*)(p.ws + WS_XN);
    f32x4 gg[4], bb[4], gv[4], shv[4], scv[4];
#pragma unroll
    for (int j = 0; j < 4; ++j) { gg[j] = ((const f32x4*)g)[lane + 64 * j]; bb[j] = ((const f32x4*)b)[lane + 64 * j]; gv[j] = shv[j] = scv[j] = (f32x4){0.f, 0.f, 0.f, 0.f}; }
    int cur_mrow = -1;
    f32x4 xn_[2][4]; u32x2 tn_[2][4];
#pragma unroll
    for (int u = 0; u < 2; ++u) { const int r = 2 * gw + u; const int rr = r < nrows ? r : 0; const f32x4* xr = (const f32x4*)xrow_ptr(p, rr) + lane; const u32x2* tr = (const u32x2*)(T + (size_t)rr * D) + lane;
#pragma unroll
        for (int j = 0; j < 4; ++j) { xn_[u][j] = __builtin_nontemporal_load(xr + 64 * j); tn_[u][j] = __builtin_nontemporal_load(tr + 64 * j); } }
    for (int r0 = 2 * gw; r0 < nrows; r0 += 2 * NGW) {
        const int rr[2] = {r0, r0 + 1};
        f32x4 v[2][4]; u32x2 t[2][4];
#pragma unroll
        for (int u = 0; u < 2; ++u)
#pragma unroll
            for (int j = 0; j < 4; ++j) { v[u][j] = xn_[u][j]; t[u][j] = tn_[u][j]; }
#pragma unroll
        for (int u = 0; u < 2; ++u) { const int rn = r0 + 2 * NGW + u; const int rq = rn < nrows ? rn : 0; const f32x4* xr = (const f32x4*)xrow_ptr(p, rq) + lane; const u32x2* tr = (const u32x2*)(T + (size_t)rq * D) + lane;
#pragma unroll
            for (int j = 0; j < 4; ++j) { xn_[u][j] = __builtin_nontemporal_load(xr + 64 * j); tn_[u][j] = __builtin_nontemporal_load(tr + 64 * j); } }
        const int mr = mod_row(r0);
        if (mr != cur_mrow) {
            cur_mrow = mr;
            const f32x4* gt = (const f32x4*)mod_ptr(p, l, r0, gate_idx) + lane;
#pragma unroll
            for (int j = 0; j < 4; ++j) gv[j] = gt[64 * j];
            if (nl >= 0) { const f32x4* sh = (const f32x4*)mod_ptr(p, nl, r0, shift_idx) + lane; const f32x4* sc = (const f32x4*)mod_ptr(p, nl, r0, scale_idx) + lane;
#pragma unroll
                for (int j = 0; j < 4; ++j) { shv[j] = sh[64 * j]; scv[j] = sc[64 * j] + 1.0f; } }
        }
        float s[2];
#pragma unroll
        for (int u = 0; u < 2; ++u) { s[u] = 0.f;
#pragma unroll
            for (int j = 0; j < 4; ++j) { f32x4 tv; tv[0] = __builtin_bit_cast(float, t[u][j].x << 16); tv[1] = __builtin_bit_cast(float, t[u][j].x & 0xffff0000u); tv[2] = __builtin_bit_cast(float, t[u][j].y << 16); tv[3] = __builtin_bit_cast(float, t[u][j].y & 0xffff0000u);
                v[u][j] = v[u][j] * ALPHA + gv[j] * tv; s[u] += (v[u][j][0] + v[u][j][1]) + (v[u][j][2] + v[u][j][3]); } }
        wave_sum2(s[0], s[1]);
        float q[2];
#pragma unroll
        for (int u = 0; u < 2; ++u) { const float mean = s[u] * (1.0f / D); q[u] = 0.f;
#pragma unroll
            for (int j = 0; j < 4; ++j) { v[u][j] = v[u][j] - mean; q[u] += (v[u][j][0] * v[u][j][0] + v[u][j][1] * v[u][j][1]) + (v[u][j][2] * v[u][j][2] + v[u][j][3] * v[u][j][3]); } }
        wave_sum2(q[0], q[1]);
#pragma unroll
        for (int u = 0; u < 2; ++u) { const float rstd = rsqrtf(q[u] * (1.0f / D) + LN_EPS); f32x4* xr = (f32x4*)xrow_ptr(p, rr[u]) + lane;
#pragma unroll
            for (int j = 0; j < 4; ++j) { v[u][j] = v[u][j] * rstd * gg[j] + bb[j]; __builtin_nontemporal_store(v[u][j], xr + 64 * j); } }
        if (nl >= 0) {
#pragma unroll
            for (int u = 0; u < 2; ++u) { s[u] = 0.f;
#pragma unroll
                for (int j = 0; j < 4; ++j) s[u] += (v[u][j][0] + v[u][j][1]) + (v[u][j][2] + v[u][j][3]); }
            wave_sum2(s[0], s[1]);
#pragma unroll
            for (int u = 0; u < 2; ++u) { const float mean = s[u] * (1.0f / D); q[u] = 0.f;
#pragma unroll
                for (int j = 0; j < 4; ++j) { v[u][j] = v[u][j] - mean; q[u] += (v[u][j][0] * v[u][j][0] + v[u][j][1] * v[u][j][1]) + (v[u][j][2] * v[u][j][2] + v[u][j][3] * v[u][j][3]); } }
            wave_sum2(q[0], q[1]);
#pragma unroll
            for (int u = 0; u < 2; ++u) { const float rstd = rsqrtf(q[u] * (1.0f / D) + LN_EPS); u32x2* o = (u32x2*)((bf16_t*)(p.ws + WS_XN) + (size_t)rr[u] * D) + lane;
#pragma unroll
                for (int j = 0; j < 4; ++j) { const f32x4 y = v[u][j] * rstd * scv[j] + shv[j]; u32x2 w; w.x = pk2(y[0], y[1]); w.y = pk2(y[2], y[3]); o[64 * j] = w; } }
        }
    }
}

__device__ __forceinline__ void chunk_info(int cidx, int& r0, int& s0, int& L) {
    r0 = cidx * CHUNK;
    if (cidx < NLAT / CHUNK) { s0 = (cidx >> 6) * SEQ; L = SEQ; } else { s0 = NLAT + ((cidx - NLAT / CHUNK) >> 1) * CTX; L = CTX; }
}
__device__ __forceinline__ float sigmoid_fast(float v) { return __builtin_amdgcn_rcpf(1.0f + __builtin_amdgcn_exp2f(-1.44269504089f * v)); }
__device__ __forceinline__ float gelu_fast(float v) {
    const float av = fabsf(v), t = __builtin_amdgcn_rcpf(av * 0.2316418882f + 1.0f);
    float q = t * 0.5307027145f + (-0.7265760135f); q = q * t + 0.7107068705f; q = q * t + (-0.142248368f); q = q * t + 0.127414796f; q = q * t;
    const float e = __builtin_amdgcn_exp2f((v * v) * (-0.72134752044f)); const float m = v * (q * e);
    return v < 0.f ? m : v - m;
}

template <int DIR>
__device__ __forceinline__ void scan_item(const Params& p, int l, int cidx, int h, float* wl, int lane) {
    int r0, s0, L; chunk_info(cidx, r0, s0, L); const int t0 = r0 - s0;
    const int ch = h * 64 + lane;
    const bf16_t* P = (const bf16_t*)(p.ws + WS_P);
    const float* sm = (const float*)(p.ws + WS_SM) + (size_t)l * SM_PER_LAYER;
    const float* cw = sm + SM_CONVW + ch; const float cw0 = cw[0], cw1 = cw[DA], cw2 = cw[2 * DA], cw3 = cw[3 * DA], cb = sm[SM_CONVB + ch];
    const float ba = sm[SM_BA + DIR * DA + ch], bx = sm[SM_BX + DIR * DA + ch], sp8 = sm[SM_SP8 + DIR * DA + ch];
    pg8::bf16x8 wfa[4][2], wfx[4][2];
    { const bf16_t* wga = (const bf16_t*)(p.ws + WS_WG) + (((size_t)(l * 2 + DIR) * 8 + h) * 64) * 64; const bf16_t* wgx = wga + (size_t)DEPTH * 2 * 8 * 64 * 64;
#pragma unroll
      for (int nt = 0; nt < 4; ++nt)
#pragma unroll
          for (int ks = 0; ks < 2; ++ks) { const int o = (16 * nt + (lane & 15)) * 64 + 32 * ks + 8 * (lane >> 4); wfa[nt][ks] = *(const pg8::bf16x8*)(wga + o); wfx[nt][ks] = *(const pg8::bf16x8*)(wgx + o); } }
    float* zaL = wl + 16 * 68; float* zxL = wl + 32 * 68;
    float* agg = (float*)(p.ws + WS_AGG);
    float hst = 0.f, Ap = 1.f;
    const __amdgpu_buffer_rsrc_t hrs = __builtin_amdgcn_make_buffer_rsrc(p.ws, 0, 0x7fffffff, 0x00020000); const unsigned hbase = (unsigned)(DIR == 0 ? WS_HF : WS_AF) + (unsigned)(r0 * DA + ch) * 4u;
    bf16_t xn[19];
    const unsigned pvo = (unsigned)WS_P + (unsigned)ch * 2u;
    { const int s = DIR ? 7 : 0; const int tb = t0 + 16 * s - 2;
#pragma unroll
      for (int i = 0; i < 19; ++i) { int tc = tb + i; tc = tc < 0 ? 0 : tc; tc = tc > L - 1 ? L - 1 : tc; xn[i] = __builtin_amdgcn_raw_buffer_load_b16(hrs, (int)pvo, (s0 + tc) * (DIN * 2), 0); } }
#pragma unroll 1
    for (int si = 0; si < 8; ++si) {
        const int s = DIR ? 7 - si : si;
        float xw[19];
#pragma unroll
        for (int i = 0; i < 19; ++i) { const int t = t0 + 16 * s - 2 + i; const float okf = (t >= 0 && t < L) ? 1.0f : 0.0f; xw[i] = bf2f(xn[i]) * okf; }
        if (si < 7) { const int s2 = DIR ? 6 - si : si + 1; const int tb = t0 + 16 * s2 - 2;
#pragma unroll
            for (int i = 0; i < 19; ++i) { int tc = tb + i; tc = tc < 0 ? 0 : tc; tc = tc > L - 1 ? L - 1 : tc; xn[i] = __builtin_amdgcn_raw_buffer_load_b16(hrs, (int)pvo, (s0 + tc) * (DIN * 2), 0); } }
#pragma unroll
        for (int tt = 0; tt < 16; ++tt) wl[tt * 68 + lane] = cb + cw0 * xw[tt] + cw1 * xw[tt + 1] + cw2 * xw[tt + 2] + cw3 * xw[tt + 3];
        asm volatile("s_waitcnt lgkmcnt(0)" ::: "memory");
        {
            pg8::bf16x8 af[2];
#pragma unroll
            for (int ks = 0; ks < 2; ++ks) { const float* xp = wl + (lane & 15) * 68 + 32 * ks + 8 * (lane >> 4); const f32x4 x0 = *(const f32x4*)xp, x1 = *(const f32x4*)(xp + 4);
                const unsigned w0 = pk2(x0[0], x0[1]), w1 = pk2(x0[2], x0[3]), w2 = pk2(x1[0], x1[1]), w3 = pk2(x1[2], x1[3]);
                u32x4 t; t.x = w0; t.y = w1; t.z = w2; t.w = w3; af[ks] = __builtin_bit_cast(pg8::bf16x8, t); }
#pragma unroll
            for (int nt = 0; nt < 4; ++nt) { pg8::f32x4 ca = {0.f, 0.f, 0.f, 0.f}, cx = {0.f, 0.f, 0.f, 0.f};
#pragma unroll
                for (int ks = 0; ks < 2; ++ks) { ca = __builtin_amdgcn_mfma_f32_16x16x32_bf16(af[ks], wfa[nt][ks], ca, 0, 0, 0); cx = __builtin_amdgcn_mfma_f32_16x16x32_bf16(af[ks], wfx[nt][ks], cx, 0, 0, 0); }
#pragma unroll
                for (int rg_ = 0; rg_ < 4; ++rg_) { const int o = (4 * (lane >> 4) + rg_) * 68 + 16 * nt + (lane & 15); zaL[o] = ca[rg_]; zxL[o] = cx[rg_]; } }
        }
        asm volatile("s_waitcnt lgkmcnt(0)" ::: "memory");
#pragma unroll
        for (int ti = 0; ti < 16; ti += 2) {
            typedef float f32x2 __attribute__((ext_vector_type(2)));
            const int ta_ = DIR ? 15 - ti : ti, tb_ = DIR ? 14 - ti : ti + 1;
            const f32x2 za = (f32x2){zaL[ta_ * 68 + lane], zaL[tb_ * 68 + lane]} + ba, zx = (f32x2){zxL[ta_ * 68 + lane], zxL[tb_ * 68 + lane]} + bx;
            const f32x2 xo = (f32x2){wl[ta_ * 68 + lane], wl[tb_ * 68 + lane]};
            const f32x2 ea = za * (-1.44269504089f), ex = zx * (-1.44269504089f);
            f32x2 da, dx; da.x = __builtin_amdgcn_exp2f(ea.x); da.y = __builtin_amdgcn_exp2f(ea.y); dx.x = __builtin_amdgcn_exp2f(ex.x); dx.y = __builtin_amdgcn_exp2f(ex.y);
            da = da + 1.0f; dx = dx + 1.0f;
            f32x2 rg, ig; rg.x = __builtin_amdgcn_rcpf(da.x); rg.y = __builtin_amdgcn_rcpf(da.y); ig.x = __builtin_amdgcn_rcpf(dx.x); ig.y = __builtin_amdgcn_rcpf(dx.y);
            const f32x2 la = rg * (sp8 * 1.44269504089f);
            f32x2 a; a.x = __builtin_amdgcn_exp2f(la.x); a.y = __builtin_amdgcn_exp2f(la.y);
            const f32x2 om = 1.0f - a * a;
            f32x2 sq; sq.x = __builtin_amdgcn_sqrtf(om.x); sq.y = __builtin_amdgcn_sqrtf(om.y);
            const f32x2 u = sq * (ig * xo);
            hst = a.x * hst + u.x; Ap *= a.x; __builtin_amdgcn_raw_buffer_store_b32(pg8::cvt_pk_bf16(hst, Ap), hrs, (int)(hbase + (unsigned)(16 * s * DA) * 4u), ta_ * DA * 4, 0);
            hst = a.y * hst + u.y; Ap *= a.y; __builtin_amdgcn_raw_buffer_store_b32(pg8::cvt_pk_bf16(hst, Ap), hrs, (int)(hbase + (unsigned)(16 * s * DA) * 4u), tb_ * DA * 4, 0);
        }
        asm volatile("s_waitcnt lgkmcnt(0)" ::: "memory");
    }
    { float* a = agg + ((size_t)cidx * 2 + DIR) * 2 * DA + ch; a[0] = Ap; a[DA] = hst; }
}

__device__ __forceinline__ void phase_mix1(const Params& p, int l, unsigned char* lds, int wv, int mode) {
    const int tid = opaque_tid(wv), lane = tid & 63, wave = tid >> 6, bid = blockIdx.x, G = gridDim.x;
    const int gw = bid * NWAVE + wave, NGW = G * NWAVE; const bool last = (l == DEPTH - 1);
    const bf16_t* P = (const bf16_t*)(p.ws + WS_P);
    if (mode & 1) { float* wl = (float*)lds + wave * 3264;
      const int nrounds = p.sc_rounds, nextra = p.sc_nextra, esh = p.sc_esh;
      for (int k = 0; k <= nrounds; ++k) { int it;
          if (k < nrounds) it = gw + k * NGW; else { const int e = gw >> esh; if (nextra == 0 || (e << esh) != gw || e >= nextra) break; it = nrounds * NGW + e; }
          const int cidx = it >> 4, d = (it >> 3) & 1, h = it & 7;
          if (d == 0) scan_item<0>(p, l, cidx, h, wl, lane); else scan_item<1>(p, l, cidx, h, wl, lane); } }
    __syncthreads();
    const float* tab = (const float*)(p.ws + WS_TAB); bf16_t* GT = (bf16_t*)(p.ws + WS_GT);
    if (!(mode & 2)) return;
    { bf16_t* zt = (bf16_t*)lds; constexpr int ZK = 72;
      const bf16_t* TA = (const bf16_t*)(p.ws + WS_TA);
      for (int it = bid; it < NB * 64; it += G) { const int b = it >> 6, lb = (it >> 2) & 15, cq = it & 3;
          { const int l1 = tid >> 3, l2i = tid & 7; const u32x4* src = (const u32x4*)(P + (size_t)(b * SEQ + l1 * 128 + lb * 8 + l2i) * DIN + 2 * DA + 2 * DB + cq * 64);
            u32x4 w[8];
#pragma unroll
            for (int j = 0; j < 8; ++j) w[j] = src[j];
#pragma unroll
            for (int j = 0; j < 8; ++j) { const unsigned ww[4] = {w[j].x, w[j].y, w[j].z, w[j].w};
#pragma unroll
                for (int e = 0; e < 4; ++e) { const int chl = j * 8 + 2 * e; zt[(chl * 8 + l2i) * ZK + l1] = (bf16_t)(ww[e] & 0xffffu); zt[((chl + 1) * 8 + l2i) * ZK + l1] = (bf16_t)(ww[e] >> 16); } } }
          __syncthreads();
          { int ln = lane; asm volatile("" : "+v"(ln)); const int fr = ln & 15, fq = ln >> 4;
            pg8::bf16x8 ta[8][2];
#pragma unroll
            for (int mt = 0; mt < 8; ++mt)
#pragma unroll
                for (int ks = 0; ks < 2; ++ks) ta[mt][ks] = *(const pg8::bf16x8*)(TA + (16 * mt + fr) * 64 + 32 * ks + 8 * fq);
#pragma unroll 1
            for (int nt = 0; nt < 4; ++nt) { const int n0 = 64 * wave + 16 * nt;
                const pg8::bf16x8 b0 = *(const pg8::bf16x8*)(zt + (n0 + fr) * ZK + 8 * fq), b1 = *(const pg8::bf16x8*)(zt + (n0 + fr) * ZK + 32 + 8 * fq);
                const int chl = (n0 + fr) >> 3, l2 = lb * 8 + (fr & 7);
                bf16_t* gbase = GT + ((size_t)(b * 64) * 256 + cq * 64 + chl) * 256 + 2 * l2;
#pragma unroll
                for (int mt = 0; mt < 8; ++mt) { pg8::f32x4 acc = {0.f, 0.f, 0.f, 0.f};
                    acc = __builtin_amdgcn_mfma_f32_16x16x32_bf16(ta[mt][0], b0, acc, 0, 0, 0); acc = __builtin_amdgcn_mfma_f32_16x16x32_bf16(ta[mt][1], b1, acc, 0, 0, 0);
#pragma unroll
                    for (int pr = 0; pr < 2; ++pr) { const int k1 = 8 * mt + 2 * fq + pr; const float gr = acc[2 * pr], gi = acc[2 * pr + 1]; const int ix = k1 * l2;
                        const float cs = tab[ix], sn = tab[8192 + ix];
                        *(unsigned*)(gbase + (size_t)k1 * 256 * 256) = pk2(gr * cs + gi * sn, gi * cs - gr * sn); } } } }
          __syncthreads();
      } }
    if (!last) {
        for (int i = bid * NTHR + tid; i < NB * 128 * 256; i += G * NTHR) { const int ch = i & 255, l2 = (i >> 8) & 127, b = i >> 15;
            const float z0 = bf2f(P[(size_t)(NLAT + b * CTX + l2) * DIN + 2 * DA + 2 * DB + ch]), z1 = bf2f(P[(size_t)(NLAT + b * CTX + 128 + l2) * DIN + 2 * DA + 2 * DB + ch]);
            const float g0 = z0 + z1, g1 = z0 - z1; const float c1 = tab[l2 * 32], s1 = tab[8192 + l2 * 32];
            *(unsigned*)(GT + ((size_t)((256 + b * 2 + 0) * 256 + ch)) * 256 + 2 * l2) = pk2(g0, 0.f);
            *(unsigned*)(GT + ((size_t)((256 + b * 2 + 1) * 256 + ch)) * 256 + 2 * l2) = pk2(g1 * c1, -g1 * s1); }
    }
}


__device__ __forceinline__ void phase_carry(const Params& p, int wv) {
    const int G = gridDim.x, k = (int)blockIdx.x - (G - 8); if (k < 0) return;
    const int ch = opaque_tid(wv), b = k >> 1, d = k & 1;
    const float* agg = (const float*)(p.ws + WS_AGG); float* car = (float*)(p.ws + WS_CARRY);
    const int cbase = NLAT / CHUNK + 2 * b, lbase = b * 64; float h = 0.f;
    if (d == 0) {
#pragma unroll
        for (int j = 0; j < 2; ++j) { const int c = cbase + j; const float* a = agg + ((size_t)c * 2 + 0) * 2 * DA + ch; car[((size_t)c * 2 + 0) * DA + ch] = h; h = a[0] * h + a[DA]; }
#pragma unroll 32
        for (int j = 0; j < 64; ++j) { const int c = lbase + j; const float* a = agg + ((size_t)c * 2 + 0) * 2 * DA + ch; car[((size_t)c * 2 + 0) * DA + ch] = h; h = a[0] * h + a[DA]; }
    } else {
#pragma unroll
        for (int j = 1; j >= 0; --j) { const int c = cbase + j; const float* a = agg + ((size_t)c * 2 + 1) * 2 * DA + ch; car[((size_t)c * 2 + 1) * DA + ch] = h; h = a[0] * h + a[DA]; }
#pragma unroll 32
        for (int j = 63; j >= 0; --j) { const int c = lbase + j; const float* a = agg + ((size_t)c * 2 + 1) * 2 * DA + ch; car[((size_t)c * 2 + 1) * DA + ch] = h; h = a[0] * h + a[DA]; }
    }
}

struct EpiDftB {
    static constexpr bool PERM = false, AFTER_DRAIN = false;
    bf16_t* V;
    __device__ __forceinline__ void operator()(const pg8::f32x4 (&acc)[2][2][4][2], const pg8::Unit& u, int wr, int wc, int fr, int fq) const {
        const int item = u.pn; int tok0, n1; float scale;
        if (item < 256) { tok0 = (item >> 6) * SEQ + (item & 63); n1 = 64; scale = 0.00138106793f;   }
        else { const int j = item - 256; tok0 = NLAT + (j >> 1) * CTX + (j & 1); n1 = 2; scale = 0.0078125f;   }
        const int ch0 = wc * 32 + 4 * fq;
#pragma unroll
        for (int m = 0; m < 4; ++m) { const int k2 = wr * 64 + m * 16 + fr; bf16_t* rowp = V + (size_t)(tok0 + n1 * k2) * 512 + 2 * ch0;
#pragma unroll
            for (int bj = 0; bj < 2; ++bj)
#pragma unroll
                for (int n = 0; n < 2; ++n) { const pg8::f32x4 re = acc[0][bj][m][n] * scale, im = acc[1][bj][m][n] * scale;
                    pg8::u32x4 w; w.x = pk2(re[0], im[0]); w.y = pk2(re[1], im[1]); w.z = pk2(re[2], im[2]); w.w = pk2(re[3], im[3]);
                    *(pg8::u32x4*)(rowp + 2 * (bj * 128 + n * 16)) = w; } }
    }
};

__device__ __forceinline__ void phase_mix3(const Params& p, int l, unsigned char* lds, int wv, int mode) {
    const int tid = opaque_tid(wv), lane = tid & 63, wave = tid >> 6, bid = blockIdx.x, G = gridDim.x;
    const bool last = (l == DEPTH - 1);
    const int nchunk = last ? NLAT / CHUNK : NCHUNK;
    constexpr int VQ = 136;
    bf16_t* vt = (bf16_t*)lds;
    bf16_t* mt = vt + 4 * 64 * VQ;
    const bf16_t* P = (const bf16_t*)(p.ws + WS_P); const unsigned* HAF = (const unsigned*)(p.ws + WS_HF); const unsigned* HAB = (const unsigned*)(p.ws + WS_AF);
    const float* car = (const float*)(p.ws + WS_CARRY);
    const bf16_t* V = (const bf16_t*)(p.ws + WS_V); bf16_t* Y = (bf16_t*)(p.ws + WS_Y);
    const bf16_t* WsB = (const bf16_t*)(p.ws + WS_SGWB) + (size_t)l * 4 * CHUNK * CHUNK; const bf16_t* MMT = (const bf16_t*)(p.ws + WS_MMT) + (size_t)l * 4 * 64 * 128;
    const float* sm = (const float*)(p.ws + WS_SM) + (size_t)l * SM_PER_LAYER; const float* gm = sm + SM_GMIX; const float* bsb = sm + SM_SGB;
    for (int i = tid; i < 4 * 64 * 16; i += NTHR) { const int row = i >> 4, c8 = (i & 15) * 8; *(u32x4*)(mt + row * VQ + c8) = *(const u32x4*)(MMT + (size_t)row * 128 + c8); }
    const int nlat = NLAT / CHUNK, nitems = last ? nlat : nlat + 3 * (NCHUNK - NLAT / CHUNK);
    for (int it = bid; it < nitems; it += G) {
        int cidx = it, md_ = mode;
        if (it >= nlat) { const int e = it - nlat, part = e >> 3; cidx = nlat + (e & 7); md_ = mode & (part == 0 ? 3 : part == 1 ? 4 : 8); }
        const int r0 = cidx * CHUNK, rw = r0 + 16 * wave;
#pragma unroll 1
        for (int pass = 0; pass < 2; ++pass) {
        if (pass == (bid & 1)) {
        pg8::bf16x8 wfr[16], vfr[16];
        { int ln = lane; asm volatile("" : "+v"(ln)); const int fr = ln & 15, fq = ln >> 4, prow = 16 * wave + fr;
#pragma unroll
          for (int h = 0; h < 4; ++h)
#pragma unroll
              for (int ks = 0; ks < 4; ++ks) { wfr[h * 4 + ks] = *(const pg8::bf16x8*)(WsB + ((size_t)(h * CHUNK + prow)) * CHUNK + 32 * ks + 8 * fq);
                  vfr[h * 4 + ks] = *(const pg8::bf16x8*)(V + (size_t)(r0 + prow) * 512 + h * 128 + 32 * ks + 8 * fq); } }
        if (md_ & 1) { u32x2 vr[16];
#pragma unroll
          for (int i = 0; i < 16; ++i) vr[i] = *(const u32x2*)(P + (size_t)(rw + i) * DIN + 2 * DA + DB + lane * 4);
#pragma unroll
          for (int i = 0; i < 16; ++i) { float v0 = gelu_fast(__builtin_bit_cast(float, vr[i].x << 16)), v1 = gelu_fast(__builtin_bit_cast(float, vr[i].x & 0xffff0000u)), v2 = gelu_fast(__builtin_bit_cast(float, vr[i].y << 16)), v3 = gelu_fast(__builtin_bit_cast(float, vr[i].y & 0xffff0000u));
              float sm_ = (v0 + v1) + (v2 + v3); sm_ += __shfl_xor(sm_, 1); sm_ += __shfl_xor(sm_, 2); sm_ += __shfl_xor(sm_, 4); sm_ += __shfl_xor(sm_, 8);
              const float mean = sm_ * (1.0f / 64.0f); v0 -= mean; v1 -= mean; v2 -= mean; v3 -= mean;
              float q_ = (v0 * v0 + v1 * v1) + (v2 * v2 + v3 * v3); q_ += __shfl_xor(q_, 1); q_ += __shfl_xor(q_, 2); q_ += __shfl_xor(q_, 4); q_ += __shfl_xor(q_, 8);
              const float rstd = rsqrtf(q_ * (1.0f / 64.0f) + LN_EPS); bf16_t* vp = vt + (lane * 4) * VQ + 16 * wave + i;
              vp[0] = f2bf(v0 * rstd); vp[VQ] = f2bf(v1 * rstd); vp[2 * VQ] = f2bf(v2 * rstd); vp[3 * VQ] = f2bf(v3 * rstd); } }
        __syncthreads();
        pg8::f32x4 acc[16];
        if (md_ & 2) { int ln = lane; asm volatile("" : "+v"(ln)); const int fr = ln & 15, fq = ln >> 4, prow = 16 * wave + fr; bf16_t* yr = Y + (size_t)(r0 + prow) * D;
#pragma unroll
        for (int i = 0; i < 16; ++i) acc[i] = (pg8::f32x4){0.f, 0.f, 0.f, 0.f};
#pragma unroll
        for (int h = 0; h < 4; ++h)
#pragma unroll
            for (int ks = 0; ks < 4; ++ks) { const pg8::bf16x8 bfr = wfr[h * 4 + ks];
#pragma unroll
                for (int nt = 0; nt < 4; ++nt) { const pg8::bf16x8 afr = *(const pg8::bf16x8*)(vt + (h * 64 + 16 * nt + fr) * VQ + 32 * ks + 8 * fq);
                    acc[h * 4 + nt] = __builtin_amdgcn_mfma_f32_16x16x32_bf16(afr, bfr, acc[h * 4 + nt], 0, 0, 0); }
                if (ks == 3) asm volatile("" ::: "memory"); }
        { float s2 = 0.f;
#pragma unroll
          for (int h = 0; h < 4; ++h) { const float bsv = bsb[h * CHUNK + prow];
#pragma unroll
              for (int nt = 0; nt < 4; ++nt) { const u32x2 uw = *(const u32x2*)(P + (size_t)(r0 + prow) * DIN + 2 * DA + h * 64 + 16 * nt + 4 * fq);
                  const float u0 = __builtin_bit_cast(float, uw.x << 16), u1 = __builtin_bit_cast(float, uw.x & 0xffff0000u), u2 = __builtin_bit_cast(float, uw.y << 16), u3 = __builtin_bit_cast(float, uw.y & 0xffff0000u);
                  pg8::f32x4 y; y[0] = gelu_fast(u0) * (acc[h * 4 + nt][0] + bsv); y[1] = gelu_fast(u1) * (acc[h * 4 + nt][1] + bsv); y[2] = gelu_fast(u2) * (acc[h * 4 + nt][2] + bsv); y[3] = gelu_fast(u3) * (acc[h * 4 + nt][3] + bsv);
                  acc[h * 4 + nt] = y; s2 += (y[0] * y[0] + y[1] * y[1]) + (y[2] * y[2] + y[3] * y[3]); } }
          s2 += __shfl_xor(s2, 16); s2 += __shfl_xor(s2, 32);
          const float rb = rsqrtf(s2 * (1.0f / DB) + LN_EPS);
#pragma unroll
          for (int i = 0; i < 16; ++i) { const int col = DA + (i >> 2) * 64 + 16 * (i & 3) + 4 * fq; const f32x4 g4 = *(const f32x4*)(gm + col);
              u32x2 o; o.x = pk2(acc[i][0] * rb * g4[0], acc[i][1] * rb * g4[1]); o.y = pk2(acc[i][2] * rb * g4[2], acc[i][3] * rb * g4[3]); *(u32x2*)(yr + col) = o; } } }
        asm volatile("" ::: "memory");
        if (md_ & 4) { int ln = lane; asm volatile("" : "+v"(ln)); const int fr = ln & 15, fq = ln >> 4, prow = 16 * wave + fr; bf16_t* yr = Y + (size_t)(r0 + prow) * D;
#pragma unroll
        for (int i = 0; i < 16; ++i) acc[i] = (pg8::f32x4){0.f, 0.f, 0.f, 0.f};
#pragma unroll
        for (int h = 0; h < 4; ++h)
#pragma unroll
            for (int ks = 0; ks < 4; ++ks) { const pg8::bf16x8 bfr = vfr[h * 4 + ks];
#pragma unroll
                for (int nt = 0; nt < 4; ++nt) { const pg8::bf16x8 afr = *(const pg8::bf16x8*)(mt + (h * 64 + 16 * nt + fr) * VQ + 32 * ks + 8 * fq);
                    acc[h * 4 + nt] = __builtin_amdgcn_mfma_f32_16x16x32_bf16(afr, bfr, acc[h * 4 + nt], 0, 0, 0); }
                if (ks == 3) asm volatile("" ::: "memory"); }
        { float s2 = 0.f;
#pragma unroll
          for (int i = 0; i < 16; ++i) s2 += (acc[i][0] * acc[i][0] + acc[i][1] * acc[i][1]) + (acc[i][2] * acc[i][2] + acc[i][3] * acc[i][3]);
          s2 += __shfl_xor(s2, 16); s2 += __shfl_xor(s2, 32);
          const float rc = rsqrtf(s2 * (1.0f / DC) + LN_EPS);
#pragma unroll
          for (int i = 0; i < 16; ++i) { const int col = DA + DB + (i >> 2) * 64 + 16 * (i & 3) + 4 * fq; const f32x4 g4 = *(const f32x4*)(gm + col);
              u32x2 o; o.x = pk2(acc[i][0] * rc * g4[0], acc[i][1] * rc * g4[1]); o.y = pk2(acc[i][2] * rc * g4[2], acc[i][3] * rc * g4[3]); *(u32x2*)(yr + col) = o; } } }
        asm volatile("" ::: "memory");
        } else {
        if (md_ & 8) { float cf[8], cbk[8];
#pragma unroll
          for (int k = 0; k < 8; ++k) { cf[k] = car[((size_t)cidx * 2 + 0) * DA + lane * 8 + k]; cbk[k] = car[((size_t)cidx * 2 + 1) * DA + lane * 8 + k]; }
#pragma unroll 4
        for (int i = 0; i < 16; ++i) { const int r = rw + i; float ya[8]; float sa2 = 0.f;
            const u32x4 gq = *(const u32x4*)(P + (size_t)r * DIN + DA + lane * 8);
            const u32x4 f0 = *(const u32x4*)(HAF + (size_t)r * DA + lane * 8), f1 = *(const u32x4*)(HAF + (size_t)r * DA + lane * 8 + 4), b0 = *(const u32x4*)(HAB + (size_t)r * DA + lane * 8), b1 = *(const u32x4*)(HAB + (size_t)r * DA + lane * 8 + 4);
            const unsigned gg[4] = {gq.x, gq.y, gq.z, gq.w}, ff[8] = {f0.x, f0.y, f0.z, f0.w, f1.x, f1.y, f1.z, f1.w}, bb[8] = {b0.x, b0.y, b0.z, b0.w, b1.x, b1.y, b1.z, b1.w};
#pragma unroll
            for (int k = 0; k < 4; ++k) { const float g0 = __builtin_bit_cast(float, gg[k] << 16), g1 = __builtin_bit_cast(float, gg[k] & 0xffff0000u);
                const float h0 = (__builtin_bit_cast(float, ff[2 * k] << 16) + __builtin_bit_cast(float, ff[2 * k] & 0xffff0000u) * cf[2 * k]) + (__builtin_bit_cast(float, bb[2 * k] << 16) + __builtin_bit_cast(float, bb[2 * k] & 0xffff0000u) * cbk[2 * k]);
                const float h1 = (__builtin_bit_cast(float, ff[2 * k + 1] << 16) + __builtin_bit_cast(float, ff[2 * k + 1] & 0xffff0000u) * cf[2 * k + 1]) + (__builtin_bit_cast(float, bb[2 * k + 1] << 16) + __builtin_bit_cast(float, bb[2 * k + 1] & 0xffff0000u) * cbk[2 * k + 1]);
                ya[2 * k] = gelu_fast(g0) * h0; ya[2 * k + 1] = gelu_fast(g1) * h1; sa2 += ya[2 * k] * ya[2 * k] + ya[2 * k + 1] * ya[2 * k + 1]; }
            const float ra = rsqrtf(wave_sum(sa2) * (1.0f / DA) + LN_EPS);
            const f32x4 g0 = *(const f32x4*)(gm + lane * 8), g1 = *(const f32x4*)(gm + lane * 8 + 4);
            u32x4 o; o.x = pk2(ya[0] * ra * g0[0], ya[1] * ra * g0[1]); o.y = pk2(ya[2] * ra * g0[2], ya[3] * ra * g0[3]); o.z = pk2(ya[4] * ra * g1[0], ya[5] * ra * g1[1]); o.w = pk2(ya[6] * ra * g1[2], ya[7] * ra * g1[3]);
            *(u32x4*)(Y + (size_t)r * D + lane * 8) = o; } }
        }
        }
        __syncthreads();
    }
}

constexpr int PH_PER_LAYER = 9, N_PHASES = 2 + PH_PER_LAYER * DEPTH;

#define XB_TMO      128
#define XB_XCNT(j)  (256  + 64 * (j))
#define XB_XSUB(j)  (1280 + 64 * (j))
#define XB_XGEN(j)  (2304 + 64 * (j))
#define XB_TOP      3328
#define XB_TOPGEN   3392
#define XCD_BAR_WORDS 3456
#define XB_SPIN_CAP (1u << 18)
__device__ __forceinline__ unsigned xb_ld(unsigned* p)              { return __hip_atomic_load(p, __ATOMIC_RELAXED, __HIP_MEMORY_SCOPE_AGENT); }
__device__ __forceinline__ unsigned xb_add(unsigned* p, unsigned v) { return __hip_atomic_fetch_add(p, v, __ATOMIC_RELAXED, __HIP_MEMORY_SCOPE_AGENT); }
__device__ __forceinline__ unsigned xb_xcc_id() { return (unsigned)__builtin_amdgcn_s_getreg((3 << 11) | 20) & 0xFu; }
#define XB_SPIN(cond, bar) do { unsigned _sp = 0; while (cond) { __builtin_amdgcn_s_sleep(1); \
    if ((++_sp & 255u) == 0u) { if (xb_ld(&(bar)[XB_TMO])) break; if (_sp > XB_SPIN_CAP) { atomicAdd(&(bar)[XB_TMO], 1u); break; } } } } while (0)
__device__ __forceinline__ void xcd_barrier_complete(unsigned* bar, unsigned x, unsigned& nloc, unsigned& nx) {
    const unsigned G = gridDim.x;
    unsigned sum, cnt, mine, sp = 0u;
    for (;;) {
        sum = 0u; cnt = 0u; mine = 0u;
#pragma unroll
        for (unsigned j = 0; j < 16; ++j) { const unsigned c = xb_ld(&bar[XB_XCNT(j)]); sum += c; cnt += (c > 0u) ? 1u : 0u; mine = (j == x) ? c : mine; }
        if (sum == G) break;
        __builtin_amdgcn_s_sleep(1);
        if ((++sp & 255u) == 0u) { if (xb_ld(&bar[XB_TMO])) break; if (sp > XB_SPIN_CAP) { atomicAdd(&bar[XB_TMO], 1u); break; } }
    }
    nloc = mine > 0u ? mine : 1u; nx = cnt > 0u ? cnt : 1u;
}
__device__ __forceinline__ void xcd_barrier(unsigned* bar, unsigned x, volatile PG8_LAS unsigned* st, bool t0) {
    asm volatile("s_waitcnt vmcnt(0)" ::: "memory");
    __syncthreads();
    if (t0) {
        __builtin_amdgcn_s_waitcnt(0);
        unsigned nloc = st[0], nx = st[1];
        if (nloc == 0u) { xcd_barrier_complete(bar, x, nloc, nx); st[0] = nloc; st[1] = nx; }
        const unsigned old = xb_add(&bar[XB_XSUB(x)], 1u);
        const unsigned gen = old / nloc;
        if (old + 1u == (gen + 1u) * nloc) {
            __builtin_amdgcn_fence(__ATOMIC_RELEASE, "agent");
            asm volatile("s_waitcnt vmcnt(0)" ::: "memory");
            const unsigned og = xb_add(&bar[XB_TOP], 1u);
            const unsigned tg = og / nx;
            if (og + 1u == (tg + 1u) * nx) xb_add(&bar[XB_TOPGEN], 1u);
            else XB_SPIN(xb_ld(&bar[XB_TOPGEN]) == tg, bar);
            __builtin_amdgcn_fence(__ATOMIC_ACQUIRE, "agent");
            xb_add(&bar[XB_XGEN(x)], 1u);
            asm volatile("s_waitcnt vmcnt(0)" ::: "memory");
        } else {
            XB_SPIN(xb_ld(&bar[XB_XGEN(x)]) == gen, bar);
            __builtin_amdgcn_fence(__ATOMIC_ACQUIRE, "agent");
            asm volatile("s_waitcnt vmcnt(0)" ::: "memory");
        }
    }
    __syncthreads();
}

__global__ void __launch_bounds__(NTHR, 2) mega(Params p) {
    extern __shared__ __attribute__((aligned(16))) unsigned char lds[];
    cg::grid_group grid = cg::this_grid();
    const int lo = p.ph_lo, hi = p.ph_hi, G = gridDim.x, bid = blockIdx.x;
    const int wv = __builtin_amdgcn_readfirstlane((int)(threadIdx.x >> 6));
    PG8_LAS unsigned char* gl = (PG8_LAS unsigned char*)lds;
#define IN(k) (lo <= (k) && (k) < hi)
    volatile PG8_LAS unsigned* xst = (volatile PG8_LAS unsigned*)(gl + LDS_BYTES - 16);
#define T0() ((wv == 0) && (opaque_lane() == 0))
    const unsigned xcc = xb_xcc_id();
    if (T0()) { xst[0] = 0u; xst[1] = 0u; (void)xb_add((unsigned*)(p.ws + WS_BAR) + XB_XCNT(xcc), 1u); }
    __syncthreads();
    if (hi < 0) grid.sync();
#define GBAR() xcd_barrier((unsigned*)(p.ws + WS_BAR), xcc, xst, T0())
#define SEAM(k) do { if ((k) + 1 < hi) GBAR(); } while (0)
#define PHASE(kind, idx, ...) do { if (IN(idx)) { const int nrep_ = ((kind) == p.dup_k) ? p.dup_n : 1; for (int rep_ = 0; rep_ < nrep_; ++rep_) { if (rep_) GBAR(); Params q = p; asm volatile("" : "+s"(q.ws), "+s"(q.out));   __VA_ARGS__ } SEAM(idx); } } while (0)
    PHASE(9, 0, phase_prologue(q, lds, wv););
    PHASE(10, 1, phase_lnmod0(q, wv););
#pragma unroll 1
    for (int l = 0; l < DEPTH; ++l) {
        const int pb = 2 + PH_PER_LAYER * l; const bool last = (l == DEPTH - 1);
        const int mrows = last ? NLAT : NTOK;
        PHASE(0, pb + 0,
            pg8::Gemm g{(const bf16_t*)(q.ws + WS_XN), (const bf16_t*)(q.ws + WS_WIN) + (size_t)l * DIN * D, NTOK, DIN, D, 0}; pg8::StaticOrder S; S.init(NTOK, DIN, G, bid);
            pg8::EpiBf16<0> E{(bf16_t*)(q.ws + WS_P), DIN, nullptr, 0, 0, 1.0f};
            pg8::gemm_phase<pg8::EpiBf16<0>, pg8::StaticOrder, true, true>(gl, g, S, E, wv););
        PHASE(1, pb + 1, phase_mix1(q, l, lds, wv, rep_ + 1 < nrep_ ? MIX1_REP_MODE : 3););
        PHASE(2, pb + 2,
            phase_carry(q, wv);
            const int nitem = last ? 256 : 264;
            pg8::Gemm g{(const bf16_t*)(q.ws + WS_T), (const bf16_t*)(q.ws + WS_GT), 256, nitem * 256, 256, 0}; pg8::StaticOrder S; S.init(256, nitem * 256, G, bid);
            EpiDftB E{(bf16_t*)(q.ws + WS_V)};
            pg8::gemm_phase<EpiDftB, pg8::StaticOrder, true, true>(gl, g, S, E, wv););
        PHASE(3, pb + 3, phase_mix3(q, l, lds, wv, rep_ + 1 < nrep_ ? MIX3_REP_MODE : 15););
        PHASE(4, pb + 4,
            pg8::Gemm g{(const bf16_t*)(q.ws + WS_Y), (const bf16_t*)(q.ws + WS_WOUT) + (size_t)l * D * D, mrows, D, D, 0}; pg8::StaticOrder S; S.init(mrows, D, G, bid);
            pg8::EpiBf16<0> E{(bf16_t*)(q.ws + WS_XN), D, nullptr, 0, 0, 1.0f};
            pg8::gemm_phase<pg8::EpiBf16<0>, pg8::StaticOrder, true, true>(gl, g, S, E, wv););
        PHASE(5, pb + 5, const float* sml = (const float*)(q.ws + WS_SM) + (size_t)l * SM_PER_LAYER; phase_ln(q, mrows, sml + SM_LN1G, sml + SM_LN1B, l, 2, l, 3, 4, wv, rep_ + 1 < nrep_ ? 1 : 0););
        PHASE(6, pb + 6,
            pg8::Gemm g{(const bf16_t*)(q.ws + WS_XN), (const bf16_t*)(q.ws + WS_WUP) + (size_t)l * 2 * DFF * D, mrows, 2 * DFF, D, 0}; pg8::StaticOrder S; S.init(mrows, 2 * DFF, G, bid);
            EpiSwiglu E{(bf16_t*)(q.ws + WS_H)};
            pg8::gemm_phase<EpiSwiglu, pg8::StaticOrder, true, true>(gl, g, S, E, wv););
        PHASE(7, pb + 7,
            pg8::Gemm g{(const bf16_t*)(q.ws + WS_H), (const bf16_t*)(q.ws + WS_WDN) + (size_t)l * D * DFF, mrows, D, DFF, 0}; pg8::StaticOrder S; S.init(mrows, D, G, bid);
            pg8::EpiBf16<0> E{(bf16_t*)(q.ws + WS_XN), D, nullptr, 0, 0, 1.0f};
            pg8::gemm_phase<pg8::EpiBf16<0>, pg8::StaticOrder, true, true>(gl, g, S, E, wv););
        PHASE(8, pb + 8, const float* sml = (const float*)(q.ws + WS_SM) + (size_t)l * SM_PER_LAYER; phase_ln(q, mrows, sml + SM_LN2G, sml + SM_LN2B, l, 5, last ? -1 : l + 1, 0, 1, wv, rep_ + 1 < nrep_ ? 1 : 0););
    }
#undef PHASE
#ifdef EXTRA_SYNCS
    for (int i = 0; i < EXTRA_SYNCS; ++i) GBAR();
#endif
#undef IN
#undef SEAM
#undef GBAR
#undef T0
}

}

extern "C" void kernel_launch(void* const* d_in, const int* in_sizes, int n_in, void* d_out, int out_size, void* d_ws, size_t ws_size, hipStream_t stream) {
    unsigned char* ws = (unsigned char*)d_ws;
    static int grid = 0;
    if (grid == 0) {
        if (n_in != 25 || in_sizes[0] != NLAT * D || out_size != NLAT * D || ws_size < WS_END) {
            fprintf(stderr, "kernel_launch: built for 25 inputs, x/out of %d floats and >= %zu bytes of workspace; got n_in %d, in0 %d, out %d, ws %zu; nothing launched\n", NLAT * D, (size_t)WS_END, n_in, n_in > 0 ? in_sizes[0] : -1, out_size, ws_size);
            grid = -1; return; }
        int dev = 0, cus = 0, per_cu = 0;
        if (hipGetDevice(&dev) != hipSuccess || hipDeviceGetAttribute(&cus, hipDeviceAttributeMultiprocessorCount, dev) != hipSuccess) { fprintf(stderr, "kernel_launch: device query failed\n"); grid = -1; return; }
        if (hipFuncSetAttribute((const void*)mega, hipFuncAttributeMaxDynamicSharedMemorySize, LDS_BYTES) != hipSuccess) fprintf(stderr, "kernel_launch: hipFuncSetAttribute failed\n");
        if (hipOccupancyMaxActiveBlocksPerMultiprocessor(&per_cu, (const void*)mega, NTHR, LDS_BYTES) != hipSuccess || per_cu < 1) { fprintf(stderr, "kernel_launch: occupancy query reports %d workgroups per CU\n", per_cu); per_cu = 1; }
        (void)hipGetLastError();
        grid = cus;
    }
    if (grid < 0) return;
    Params base{};
    for (int i = 0; i < 25; ++i) base.in[i] = (const float*)d_in[i];
    base.out = (float*)d_out; base.ws = ws;
#ifdef DUP_K
    base.dup_k = DUP_K; base.dup_n = DUP_N;
#else
    base.dup_k = -1; base.dup_n = 1;
#endif
    base.ph_lo = 0; base.ph_hi = N_PHASES;
    { const int ngw = grid * NWAVE, items = NCHUNK * 16; base.sc_rounds = items / ngw; base.sc_nextra = items - base.sc_rounds * ngw; int sh = 0; if (base.sc_nextra > 0) while ((base.sc_nextra << (sh + 1)) <= ngw) ++sh; base.sc_esh = sh; base.pad = 0; }
    if (hipMemsetAsync(ws + WS_BAR, 0, (size_t)XCD_BAR_WORDS * 4, stream) != hipSuccess) fprintf(stderr, "kernel_launch: memset of the barrier words failed\n");
    void* args[] = {&base};
    const hipError_t e = hipLaunchCooperativeKernel((const void*)mega, dim3(grid), dim3(NTHR), args, LDS_BYTES, stream);
    if (e != hipSuccess) fprintf(stderr, "kernel_launch: cooperative launch failed: %s (grid %d)\n", hipGetErrorString(e), grid);
}
```
